# Optimizing an MI355X kernel written in HIP

```python
import math
import jax, jax.numpy as jnp
from jax import lax
import numpy as np

D_MODEL = 2048
BATCH = 4
SEQ = 4096
DEPTH = 2

CHUNK = 64
N_A = DEPTH // 2
N_B = DEPTH - N_A
POOL_WINDOWS = (2, 4, 8, 16)
N_POOL_GROUPS = len(POOL_WINDOWS)
POOL_GROUP_DIM = D_MODEL // N_POOL_GROUPS
HEAD_DIM = 128
N_HEADS = D_MODEL // HEAD_DIM
D_FF = 4 * D_MODEL
Q_BLOCK = 128
EPS = 1e-6

kernel_name = "yoco_pool_stickbreaking_trunk"


def rms_norm(x, g):
    xf = x.astype(jnp.float32)
    y = xf * lax.rsqrt(jnp.mean(xf * xf, axis=-1, keepdims=True) + EPS)
    return (y * g.astype(jnp.float32)).astype(x.dtype)


def multiscale_pool_mixer(x, w_pool, scale):
    B, S, D = x.shape
    xg = x.reshape(B, S, N_POOL_GROUPS, POOL_GROUP_DIM)
    pos = jnp.arange(S)
    outs = []
    for g, w in enumerate(POOL_WINDOWS):
        xf = xg[:, :, g, :].astype(jnp.float32)
        cs = jnp.cumsum(xf, axis=1)
        lag = jnp.pad(cs, ((0, 0), (w, 0), (0, 0)))[:, :S]
        cnt = jnp.minimum(pos + 1, w).astype(jnp.float32)[None, :, None]
        diff = ((cs - lag) / cnt - xf).astype(x.dtype)
        outs.append(jnp.einsum('bsc,ce->bse', diff, w_pool[g]))
    return jnp.concatenate(outs, axis=-1) * scale


def squared_relu_mlp(x, w_up, w_down):
    h = jax.nn.relu(jnp.einsum('bsd,df->bsf', x, w_up))
    return jnp.einsum('bsf,fd->bsd', h * h, w_down)


def stick_breaking_attention(q, k, v):
    B, S, H, Dh = q.shape
    inv_sqrt = 1.0 / math.sqrt(Dh)
    outs = []
    for i in range(S // Q_BLOCK):
        q0 = i * Q_BLOCK
        end = q0 + Q_BLOCK
        qb = q[:, q0:end]
        kb = k[:, :end]
        vb = v[:, :end]
        z = jnp.einsum('bthd,bshd->bhts', qb, kb).astype(jnp.float32) * inv_sqrt
        t_idx = q0 + jnp.arange(Q_BLOCK)
        s_idx = jnp.arange(end)
        causal = s_idx[None, :] < t_idx[:, None]
        log_beta = jax.nn.log_sigmoid(z)
        log_1m = jnp.where(causal, jax.nn.log_sigmoid(-z), 0.0)
        between = lax.cumsum(log_1m, axis=3, reverse=True) - log_1m
        a = jnp.where(causal, jnp.exp(log_beta + between), 0.0)
        outs.append(jnp.einsum('bhts,bshd->bthd', a.astype(vb.dtype), vb))
    return jnp.concatenate(outs, axis=1)


def setup_inputs(seed: int = 0) -> dict:
    key = jax.random.key(seed)
    ks = jax.random.split(key, 16)
    f32 = jnp.float32

    def nrm(k, shape, fan_in):
        return jax.random.normal(k, shape, f32) * (fan_in ** -0.5)

    def gain(k, shape):
        return 1.0 + 0.05 * jax.random.normal(k, shape, f32)

    x = jax.random.normal(ks[0], (BATCH, SEQ, D_MODEL), f32)
    pool_norm = gain(ks[1], (N_A, D_MODEL))
    pool_w = nrm(ks[2], (N_A, N_POOL_GROUPS, POOL_GROUP_DIM, POOL_GROUP_DIM), POOL_GROUP_DIM)
    pool_scale = 0.5 + 0.05 * jax.random.normal(ks[3], (N_A, D_MODEL), f32)
    kv_norm = gain(ks[4], (D_MODEL,))
    w_kv = nrm(ks[5], (D_MODEL, 2 * D_MODEL), D_MODEL)
    attn_norm = gain(ks[6], (N_B, D_MODEL))
    w_q = nrm(ks[7], (N_B, D_MODEL, D_MODEL), D_MODEL)
    w_o = nrm(ks[8], (N_B, D_MODEL, D_MODEL), D_MODEL)
    mlp_norm = gain(ks[9], (DEPTH, D_MODEL))
    w_up = nrm(ks[10], (DEPTH, D_MODEL, D_FF), D_MODEL)
    w_down = nrm(ks[11], (DEPTH, D_FF, D_MODEL), D_FF)
    final_norm = gain(ks[12], (D_MODEL,))
    return {"x": x, "pool_norm": pool_norm, "pool_w": pool_w, "pool_scale": pool_scale,
            "kv_norm": kv_norm, "w_kv": w_kv, "attn_norm": attn_norm, "w_q": w_q,
            "w_o": w_o, "mlp_norm": mlp_norm, "w_up": w_up, "w_down": w_down,
            "final_norm": final_norm}


def reference(x, pool_norm, pool_w, pool_scale, kv_norm, w_kv, attn_norm, w_q, w_o,
              mlp_norm, w_up, w_down, final_norm):
    B, S, D = x.shape
    k_shared = None
    v_shared = None
    for layer in range(DEPTH):
        if layer < N_A:
            x = x + multiscale_pool_mixer(rms_norm(x, pool_norm[layer]), pool_w[layer],
                                          pool_scale[layer])
        else:
            if layer == N_A:
                kv = jnp.einsum('bsd,de->bse', rms_norm(x, kv_norm), w_kv)
                kv = kv.reshape(B, S, 2, N_HEADS, HEAD_DIM)
                k_shared = kv[:, :, 0]
                v_shared = kv[:, :, 1]
            j = layer - N_A
            q = jnp.einsum('bsd,de->bse', rms_norm(x, attn_norm[j]), w_q[j])
            q = q.reshape(B, S, N_HEADS, HEAD_DIM)
            o = stick_breaking_attention(q, k_shared, v_shared).reshape(B, S, D)
            x = x + jnp.einsum('bsd,de->bse', o, w_o[j])
        x = x + squared_relu_mlp(rms_norm(x, mlp_norm[layer]), w_up[layer], w_down[layer])
    return rms_norm(x, final_norm)
```

```cpp
#define PROBE 0
#include <hip/hip_runtime.h>
#include <hip/hip_cooperative_groups.h>
#include <cstdio>
#include <cstdint>
namespace cg = cooperative_groups;

#define LAS __attribute__((address_space(3)))
typedef unsigned short bf16_t;
typedef short bf16x8 __attribute__((ext_vector_type(8)));
typedef short s16x4 __attribute__((ext_vector_type(4)));
typedef float f32x4 __attribute__((ext_vector_type(4)));
typedef float f32x16 __attribute__((ext_vector_type(16)));
typedef unsigned u32x4 __attribute__((ext_vector_type(4)));
typedef unsigned u32x2 __attribute__((ext_vector_type(2)));

constexpr int DM = 2048, NBATCH = 4, SEQ = 4096, M = NBATCH * SEQ, FF = 8192, NH = 16, HD = 128;
constexpr float EPS = 1e-6f;
constexpr float C2 = 0.08838834764831845f * 1.4426950408889634f;

constexpr size_t MiB = 1u << 20;
constexpr size_t WS_PWT = 0;
constexpr size_t WS_WUPT = 2 * MiB;
constexpr size_t WS_WDT = 66 * MiB;
constexpr size_t WS_WKVQT = 130 * MiB;
constexpr size_t WS_WOT = 154 * MiB;
constexpr size_t WS_SSQ = 162 * MiB;
constexpr size_t WS_BAR = 162 * MiB + 512 * 1024;
constexpr size_t WS_XB = 163 * MiB;
constexpr size_t WS_H = 227 * MiB;
constexpr size_t WS_DIFF = WS_H, WS_K = WS_H, WS_V = WS_H + 64 * MiB, WS_Q = WS_H + 128 * MiB, WS_O = WS_H + 192 * MiB;
constexpr size_t WS_END = 483 * MiB;
constexpr int LDS_BYTES = 147456;

#define LDS_WAIT() asm volatile("s_waitcnt lgkmcnt(0)" ::: "memory")
__device__ __forceinline__ unsigned f2bf(float f) { unsigned u = __builtin_bit_cast(unsigned, f); return (u + 0x7fffu + ((u >> 16) & 1u)) >> 16; }
__device__ __forceinline__ unsigned pk2(float lo, float hi) { return f2bf(lo) | (f2bf(hi) << 16); }
typedef float f32x2_t __attribute__((ext_vector_type(2))); typedef __bf16 bf16x2_t __attribute__((ext_vector_type(2)));
__device__ __forceinline__ unsigned cvt_pk_bf16(float lo, float hi) { const f32x2_t v = {lo, hi}; const bf16x2_t b = __builtin_convertvector(v, bf16x2_t); return __builtin_bit_cast(unsigned, b); }
__device__ __forceinline__ float wave_sum(float v) {
#pragma unroll
    for (int o = 1; o < 64; o <<= 1) v += __shfl_xor(v, o);
    return v;
}

namespace pg8 {
constexpr int BM = 256, BK = 64, HALF = 128, HTB = HALF * BK * 2, STAGE_BYTES = 8 * HTB, NXCD = 8, WGM = 8;
__host__ __device__ __forceinline__ int lds_byte(int r, int c) { const int st = (r >> 4) * 2 + (c >> 5), rr = r & 15, cc = c & 31, ob = rr * 64 + cc * 2; return st * 1024 + (ob ^ (((ob >> 9) & 1) << 5)); }
__host__ __device__ __forceinline__ void stage_rc(int b, int& R, int& C) { const int st = b / 1024, sb = b % 1024, swz = sb ^ (((sb >> 9) & 1) << 5); R = (st >> 1) * 16 + swz / 64; C = (st & 1) * 32 + (swz % 64) / 2; }
__host__ __device__ __forceinline__ int perm32(int rho) { const int n = rho >> 4, i = rho & 15; return 8 * (i >> 2) + 4 * n + (i & 3); }

struct Unit { int pm, pn; };
struct Gemm { const bf16_t* A; const bf16_t* Bt; int M, N, K, lda, a_shift, a_cols; };

struct StaticOrder {
    int nM, nN, nwg, G, c, wgm;
    __host__ __device__ void init(int M_, int N_, int G_, int c_, int wgm_ = WGM) { nM = M_ / BM; nN = N_ / BM; nwg = nM * nN; G = G_; c = c_; wgm = wgm_; }
    __host__ __device__ bool next(int i, Unit& u) const {
        const long L = (long)i * G + c; if (L >= nwg) return false;
        int wgid = (int)L; { const int q = nwg / NXCD, r = nwg % NXCD, xcd = wgid % NXCD, off = wgid / NXCD; wgid = (xcd < r ? xcd * (q + 1) : r * (q + 1) + (xcd - r) * q) + off; }
        const int nig = wgm * nN, gid = wgid / nig, fm = gid * wgm, gsz = (nM - fm) < wgm ? (nM - fm) : wgm;
        u.pm = fm + ((wgid % nig) % gsz); u.pn = (wgid % nig) / gsz; return true;
    }
};


template <bool IN32> struct EpiRes {
    static constexpr bool PERM = true;
    const float* Xin32; bf16_t* XB; const float* scale; float* ssq; const float* rs_ssq;
    __device__ __forceinline__ void operator()(const f32x4 (&acc)[2][2][4][2], const Unit& u, int wr, int wc, int fr, int fq) const {
        const int row0 = u.pm * BM + wr * 64 + fr, col0 = u.pn * BM + wc * 32 + 8 * fq;
        f32x4 sv[2][2];
#pragma unroll
        for (int bj = 0; bj < 2; ++bj)
#pragma unroll
            for (int n = 0; n < 2; ++n) sv[bj][n] = scale ? *(const f32x4*)(scale + col0 + bj * HALF + 4 * n) : (f32x4){1.f, 1.f, 1.f, 1.f};
#pragma unroll
        for (int ai = 0; ai < 2; ++ai)
#pragma unroll
            for (int m = 0; m < 4; ++m) {
                const int row = row0 + ai * HALF + m * 16; const size_t ro = (size_t)row * DM + col0; float s = 0.f;
                const float rsc = rs_ssq ? __builtin_amdgcn_rcpf(rs_ssq[row] * (1.0f / DM) + EPS) : 1.0f;
#pragma unroll
                for (int bj = 0; bj < 2; ++bj) {
                    f32x4 r0, r1;
                    if constexpr (IN32) { r0 = *(const f32x4*)(Xin32 + ro + bj * HALF); r1 = *(const f32x4*)(Xin32 + ro + bj * HALF + 4); }
                    else { const u32x4 q = *(const u32x4*)(XB + ro + bj * HALF);
                        r0 = (f32x4){__uint_as_float(q.x << 16), __uint_as_float(q.x & 0xffff0000u), __uint_as_float(q.y << 16), __uint_as_float(q.y & 0xffff0000u)};
                        r1 = (f32x4){__uint_as_float(q.z << 16), __uint_as_float(q.z & 0xffff0000u), __uint_as_float(q.w << 16), __uint_as_float(q.w & 0xffff0000u)}; }
                    const f32x4 v0 = acc[ai][bj][m][0] * (sv[bj][0] * rsc) + r0, v1 = acc[ai][bj][m][1] * (sv[bj][1] * rsc) + r1;
                    u32x4 w; w.x = cvt_pk_bf16(v0[0], v0[1]); w.y = cvt_pk_bf16(v0[2], v0[3]); w.z = cvt_pk_bf16(v1[0], v1[1]); w.w = cvt_pk_bf16(v1[2], v1[3]); *(u32x4*)(XB + ro + bj * HALF) = w;
                    s += (v0[0] * v0[0] + v0[1] * v0[1]) + (v0[2] * v0[2] + v0[3] * v0[3]) + (v1[0] * v1[0] + v1[1] * v1[1]) + (v1[2] * v1[2] + v1[3] * v1[3]);
                }
                s += __shfl_xor(s, 16); s += __shfl_xor(s, 32);
                if (fq == 0) unsafeAtomicAdd(ssq + row, s);
            }
    }
};
struct EpiFinal {
    static constexpr bool PERM = true;
    const bf16_t* XB; const float* rs_ssq; float* ssq; unsigned* cnt; const float* gain; float* out;
    __device__ __forceinline__ void operator()(f32x4 (&acc)[2][2][4][2], const Unit& u, int wr, int wc, int fr, int fq) const {
        const int row0 = u.pm * BM + wr * 64 + fr, col0 = u.pn * BM + wc * 32 + 8 * fq;
#pragma unroll
        for (int ai = 0; ai < 2; ++ai)
#pragma unroll
            for (int m = 0; m < 4; ++m) {
                const int row = row0 + ai * HALF + m * 16; const size_t ro = (size_t)row * DM + col0; float s = 0.f;
                const float rsc = __builtin_amdgcn_rcpf(rs_ssq[row] * (1.0f / DM) + EPS);
#pragma unroll
                for (int bj = 0; bj < 2; ++bj) {
                    const u32x4 q = *(const u32x4*)(XB + ro + bj * HALF);
                    const f32x4 r0 = (f32x4){__uint_as_float(q.x << 16), __uint_as_float(q.x & 0xffff0000u), __uint_as_float(q.y << 16), __uint_as_float(q.y & 0xffff0000u)};
                    const f32x4 r1 = (f32x4){__uint_as_float(q.z << 16), __uint_as_float(q.z & 0xffff0000u), __uint_as_float(q.w << 16), __uint_as_float(q.w & 0xffff0000u)};
                    const f32x4 v0 = acc[ai][bj][m][0] * rsc + r0, v1 = acc[ai][bj][m][1] * rsc + r1;
                    acc[ai][bj][m][0] = v0; acc[ai][bj][m][1] = v1;
                    s += (v0[0] * v0[0] + v0[1] * v0[1]) + (v0[2] * v0[2] + v0[3] * v0[3]) + (v1[0] * v1[0] + v1[1] * v1[1]) + (v1[2] * v1[2] + v1[3] * v1[3]);
                }
                s += __shfl_xor(s, 16); s += __shfl_xor(s, 32);
                if (fq == 0) unsafeAtomicAdd(ssq + row, s);
            }
        asm volatile("s_waitcnt vmcnt(0)" ::: "memory");
        unsigned* pc = cnt + 64 * u.pm;
        if (fr == 0 && fq == 0) (void)__hip_atomic_fetch_add(pc, 1u, __ATOMIC_RELAXED, __HIP_MEMORY_SCOPE_AGENT);
        { unsigned sp = 0;
          while ((unsigned)__builtin_amdgcn_readfirstlane((int)__hip_atomic_load(pc, __ATOMIC_RELAXED, __HIP_MEMORY_SCOPE_AGENT)) < 64u) { __builtin_amdgcn_s_sleep(2); if (++sp > (1u << 22)) break; } }
        asm volatile("" ::: "memory");
#pragma unroll
        for (int ai = 0; ai < 2; ++ai)
#pragma unroll
            for (int m = 0; m < 4; ++m) {
                const int row = row0 + ai * HALF + m * 16; const size_t ro = (size_t)row * DM + col0;
                const float tot = __hip_atomic_load(ssq + row, __ATOMIC_RELAXED, __HIP_MEMORY_SCOPE_AGENT);
                const float rstd = __builtin_amdgcn_rsqf(tot * (1.0f / DM) + EPS);
#pragma unroll
                for (int bj = 0; bj < 2; ++bj) {
                    const f32x4 g0 = *(const f32x4*)(gain + col0 + bj * HALF), g1 = *(const f32x4*)(gain + col0 + bj * HALF + 4);
                    *(f32x4*)(out + ro + bj * HALF) = acc[ai][bj][m][0] * rstd * g0; *(f32x4*)(out + ro + bj * HALF + 4) = acc[ai][bj][m][1] * rstd * g1;
                }
            }
    }
};
struct EpiUp {
    static constexpr bool PERM = true;
    bf16_t* H;
    __device__ __forceinline__ void operator()(const f32x4 (&acc)[2][2][4][2], const Unit& u, int wr, int wc, int fr, int fq) const {
        const int row0 = u.pm * BM + wr * 64 + fr, col0 = u.pn * BM + wc * 32 + 8 * fq;
#pragma unroll
        for (int ai = 0; ai < 2; ++ai)
#pragma unroll
            for (int m = 0; m < 4; ++m) {
                const int row = row0 + ai * HALF + m * 16;
                bf16_t* rowp = H + (size_t)row * FF + col0;
#pragma unroll
                for (int bj = 0; bj < 2; ++bj) {
                    f32x4 v0 = acc[ai][bj][m][0], v1 = acc[ai][bj][m][1];
#pragma unroll
                    for (int j = 0; j < 4; ++j) { v0[j] = fmaxf(v0[j], 0.f); v0[j] *= v0[j]; v1[j] = fmaxf(v1[j], 0.f); v1[j] *= v1[j]; }
                    u32x4 w; w.x = cvt_pk_bf16(v0[0], v0[1]); w.y = cvt_pk_bf16(v0[2], v0[3]); w.z = cvt_pk_bf16(v1[0], v1[1]); w.w = cvt_pk_bf16(v1[2], v1[3]);
                    *(u32x4*)(rowp + bj * HALF) = w;
                }
            }
    }
};
struct EpiKVQ {
    static constexpr bool PERM = true;
    const float* ssq; bf16_t* KVQ;
    __device__ __forceinline__ void operator()(const f32x4 (&acc)[2][2][4][2], const Unit& u, int wr, int wc, int fr, int fq) const {
        const int row0 = u.pm * BM + wr * 64 + fr; int colt = u.pn * BM; const int t = colt / DM; colt -= t * DM;
        bf16_t* base = KVQ + (size_t)t * ((size_t)M * DM); const float sc = (t == 2) ? C2 : 1.0f;
        const int col0 = colt + wc * 32 + 8 * fq;
#pragma unroll
        for (int ai = 0; ai < 2; ++ai)
#pragma unroll
            for (int m = 0; m < 4; ++m) {
                const int row = row0 + ai * HALF + m * 16; const float rstd = __builtin_amdgcn_rsqf(ssq[row] * (1.0f / DM) + EPS) * sc;
                bf16_t* rowp = base + (size_t)row * DM + col0;
#pragma unroll
                for (int bj = 0; bj < 2; ++bj) {
                    const f32x4 v0 = acc[ai][bj][m][0] * rstd, v1 = acc[ai][bj][m][1] * rstd;
                    u32x4 w; w.x = cvt_pk_bf16(v0[0], v0[1]); w.y = cvt_pk_bf16(v0[2], v0[3]); w.z = cvt_pk_bf16(v1[0], v1[1]); w.w = cvt_pk_bf16(v1[2], v1[3]);
                    *(u32x4*)(rowp + bj * HALF) = w;
                }
            }
    }
};
template <class Epi, class Sched, bool ALIGN_EPI = false, bool SP2 = false>
__device__ __forceinline__ void gemm_phase(LAS unsigned char* lds, const Gemm g, const Sched& S, const Epi& E) {
    int tid_ = threadIdx.x; asm volatile("" : "+v"(tid_));
    const int tid = tid_, wid = __builtin_amdgcn_readfirstlane(tid >> 6), lane = tid & 63, wr = wid >> 2, wc = wid & 3, fr = lane & 15, fq = lane >> 4;
    const int K = g.K, nt = K / BK, lda = g.lda;
    unsigned voffA[2], voffB[2];
#pragma unroll
    for (int i = 0; i < 2; ++i) { int R, C; stage_rc(tid * 16 + i * 8192, R, C); const int Rb = Epi::PERM ? ((R & ~31) + perm32(R & 31)) : R;
        voffA[i] = (unsigned)(R * lda + C) * 2u; voffB[i] = (unsigned)(Rb * K + C) * 2u; }
    const size_t kstep = (size_t)(BK * 2);
    const size_t hstepA = (size_t)HALF * lda * 2, hstepB = (size_t)HALF * K * 2;
    const size_t tstepA = 2 * hstepA, tstepB = 2 * hstepB;
    const unsigned ldsw = (unsigned)wid * 1024u;
    const int aoff = lds_byte(wr * 64 + fr, fq * 8), boff = lds_byte(wc * 32 + fr, fq * 8);
#define PG8_SA(b, h) (((b) * 2 + (h)) * HTB)
#define PG8_SB(b, h) ((4 + (b) * 2 + (h)) * HTB)
#define PG8_STAGE(bufoff, gbase, voff) do { _Pragma("unroll") for (int _i = 0; _i < 2; ++_i) \
        __builtin_amdgcn_global_load_lds((const unsigned*)((const char*)(gbase) + (voff)[_i]), (LAS unsigned*)(lds + (bufoff) + ldsw + _i * 8192), 16, 0, 0); } while (0)
#define PG8_LDA(dst, b, h) do { _Pragma("unroll") for (int m = 0; m < 4; ++m) _Pragma("unroll") for (int k = 0; k < 2; ++k) dst[m][k] = *(const LAS bf16x8*)(lds + PG8_SA(b, h) + aoff + m * 2048 + k * 1024); } while (0)
#define PG8_LDB(dst, b, h) do { _Pragma("unroll") for (int n = 0; n < 2; ++n) _Pragma("unroll") for (int k = 0; k < 2; ++k) dst[n][k] = *(const LAS bf16x8*)(lds + PG8_SB(b, h) + boff + n * 2048 + k * 1024); } while (0)
#define PG8_MMA(ai, bj, At, Bt) do { __builtin_amdgcn_s_setprio(1); _Pragma("unroll") for (int m = 0; m < 4; ++m) _Pragma("unroll") for (int n = 0; n < 2; ++n) _Pragma("unroll") for (int k = 0; k < 2; ++k) \
        acc[ai][bj][m][n] = __builtin_amdgcn_mfma_f32_16x16x32_bf16(Bt[n][k], At[m][k], acc[ai][bj][m][n], 0, 0, 0); __builtin_amdgcn_s_setprio(0); } while (0)
#define PG8_WAIT_V(n) asm volatile("s_waitcnt vmcnt(" #n ")" ::: "memory")
#define PG8_WAIT_L(n) asm volatile("s_waitcnt lgkmcnt(" #n ")" ::: "memory")
#define PG8_BAR __builtin_amdgcn_s_barrier()
#define PG8_SCHED __builtin_amdgcn_sched_barrier(0)
    Unit cur, nxt; int ui = 0;
    if (!S.next(0, cur)) return;
    f32x4 acc[2][2][4][2];
#pragma unroll
    for (int a = 0; a < 2; ++a)
#pragma unroll
        for (int b = 0; b < 2; ++b)
#pragma unroll
            for (int m = 0; m < 4; ++m)
#pragma unroll
                for (int n = 0; n < 2; ++n) acc[a][b][m][n] = (f32x4){0.f, 0.f, 0.f, 0.f};
    bf16x8 At[4][2], B0[2][2], B1[2][2];
    const char* cA = (const char*)g.A + (size_t)cur.pm * tstepA + (size_t)((cur.pn >> g.a_shift) * g.a_cols) * 2; const char* cB = (const char*)g.Bt + (size_t)cur.pn * tstepB;
    if constexpr (SP2) {
        PG8_STAGE(PG8_SB(0, 0), cB, voffB); PG8_STAGE(PG8_SB(0, 1), cB + hstepB, voffB); PG8_STAGE(PG8_SA(0, 0), cA, voffA); PG8_STAGE(PG8_SA(0, 1), cA + hstepA, voffA);
        if (wr == 1) PG8_BAR;
        PG8_WAIT_V(2); PG8_BAR;
        PG8_STAGE(PG8_SB(1, 0), cB + kstep, voffB); PG8_STAGE(PG8_SA(1, 0), cA + kstep, voffA); PG8_STAGE(PG8_SB(1, 1), cB + hstepB + kstep, voffB);
        PG8_WAIT_V(6); PG8_BAR;
    } else {
        PG8_STAGE(PG8_SB(0, 0), cB, voffB); PG8_STAGE(PG8_SA(0, 0), cA, voffA); PG8_STAGE(PG8_SB(0, 1), cB + hstepB, voffB); PG8_STAGE(PG8_SA(0, 1), cA + hstepA, voffA);
        if (wr == 1) PG8_BAR;
        PG8_WAIT_V(4); PG8_BAR;
        PG8_STAGE(PG8_SB(1, 0), cB + kstep, voffB); PG8_STAGE(PG8_SA(1, 0), cA + kstep, voffA); PG8_STAGE(PG8_SB(1, 1), cB + hstepB + kstep, voffB);
        PG8_WAIT_V(6); PG8_BAR;
    }
    for (;;) {
        const bool has_next = S.next(ui + 1, nxt);
        const char* nA = has_next ? (const char*)g.A + (size_t)nxt.pm * tstepA + (size_t)((nxt.pn >> g.a_shift) * g.a_cols) * 2 : cA; const char* nB = has_next ? (const char*)g.Bt + (size_t)nxt.pn * tstepB : cB;
        for (int t = 0; t < nt; t += 2) {
            const bool last = (t == nt - 2);
            const char* a1 = cA + (size_t)(t + 1) * kstep;
            const char* a2 = last ? nA : cA + (size_t)(t + 2) * kstep; const char* b2 = last ? nB : cB + (size_t)(t + 2) * kstep;
            const char* a3 = a2 + kstep; const char* b3 = b2 + kstep;
            if constexpr (SP2) {
            PG8_LDB(B0, 0, 0); PG8_LDB(B1, 0, 1); PG8_SCHED; PG8_LDA(At, 0, 0); PG8_STAGE(PG8_SA(1, 1), a1 + hstepA, voffA);
            PG8_WAIT_V(8); PG8_WAIT_L(0); PG8_BAR; PG8_MMA(0, 0, At, B0); PG8_MMA(0, 1, At, B1); PG8_BAR; PG8_SCHED;
            PG8_LDA(At, 0, 1); PG8_STAGE(PG8_SB(0, 0), b2, voffB); PG8_STAGE(PG8_SB(0, 1), b2 + hstepB, voffB); PG8_STAGE(PG8_SA(0, 0), a2, voffA);
            PG8_WAIT_V(8); PG8_WAIT_L(0); PG8_BAR; PG8_MMA(1, 0, At, B0); PG8_MMA(1, 1, At, B1); PG8_BAR; PG8_SCHED;
            PG8_LDB(B0, 1, 0); PG8_LDB(B1, 1, 1); PG8_SCHED; PG8_LDA(At, 1, 0); PG8_STAGE(PG8_SA(0, 1), a2 + hstepA, voffA);
            PG8_WAIT_V(8); PG8_WAIT_L(0); PG8_BAR; PG8_MMA(0, 0, At, B0); PG8_MMA(0, 1, At, B1); PG8_BAR; PG8_SCHED;
            PG8_LDA(At, 1, 1); PG8_STAGE(PG8_SB(1, 0), b3, voffB); PG8_STAGE(PG8_SB(1, 1), b3 + hstepB, voffB); PG8_STAGE(PG8_SA(1, 0), a3, voffA);
            PG8_WAIT_V(8); PG8_WAIT_L(0); PG8_BAR; PG8_MMA(1, 0, At, B0); PG8_MMA(1, 1, At, B1); PG8_BAR; PG8_SCHED;
            } else {
            PG8_LDB(B0, 0, 0); PG8_SCHED; PG8_LDA(At, 0, 0); PG8_STAGE(PG8_SA(1, 1), a1 + hstepA, voffA);
            PG8_WAIT_L(8); PG8_BAR; PG8_WAIT_L(0); PG8_MMA(0, 0, At, B0); PG8_BAR; PG8_SCHED;
            PG8_LDB(B1, 0, 1); PG8_STAGE(PG8_SB(0, 0), b2, voffB);
            PG8_BAR; PG8_WAIT_L(0); PG8_MMA(0, 1, At, B1); PG8_BAR;
            PG8_LDA(At, 0, 1); PG8_STAGE(PG8_SA(0, 0), a2, voffA);
            PG8_BAR; PG8_WAIT_L(0); PG8_MMA(1, 0, At, B0); PG8_BAR; PG8_SCHED;
            PG8_STAGE(PG8_SB(0, 1), b2 + hstepB, voffB);
            PG8_WAIT_V(6); PG8_BAR; PG8_MMA(1, 1, At, B1); PG8_BAR;
            PG8_LDB(B0, 1, 0); PG8_SCHED; PG8_LDA(At, 1, 0); PG8_STAGE(PG8_SA(0, 1), a2 + hstepA, voffA);
            PG8_WAIT_L(8); PG8_BAR; PG8_WAIT_L(0); PG8_MMA(0, 0, At, B0); PG8_BAR; PG8_SCHED;
            PG8_LDB(B1, 1, 1); PG8_STAGE(PG8_SB(1, 0), b3, voffB);
            PG8_BAR; PG8_WAIT_L(0); PG8_MMA(0, 1, At, B1); PG8_BAR;
            PG8_LDA(At, 1, 1); PG8_STAGE(PG8_SA(1, 0), a3, voffA);
            PG8_BAR; PG8_WAIT_L(0); PG8_MMA(1, 0, At, B0); PG8_BAR; PG8_SCHED;
            PG8_STAGE(PG8_SB(1, 1), b3 + hstepB, voffB);
            PG8_WAIT_V(6); PG8_BAR; PG8_MMA(1, 1, At, B1); PG8_BAR;
            }
        }
        if constexpr (ALIGN_EPI) { if (wr == 0) PG8_BAR; }
        E(acc, cur, wr, wc, fr, fq);
        if (!has_next) break;
#pragma unroll
        for (int a = 0; a < 2; ++a)
#pragma unroll
            for (int b = 0; b < 2; ++b)
#pragma unroll
                for (int m = 0; m < 4; ++m)
#pragma unroll
                    for (int n = 0; n < 2; ++n) acc[a][b][m][n] = (f32x4){0.f, 0.f, 0.f, 0.f};
        cur = nxt; cA = nA; cB = nB; ++ui;
        if constexpr (ALIGN_EPI) { if (wr == 1) PG8_BAR; }
    }
    PG8_WAIT_V(0);
    if constexpr (!ALIGN_EPI) { if (wr == 0) PG8_BAR; }
    PG8_BAR;
#undef PG8_SA
#undef PG8_SB
#undef PG8_STAGE
#undef PG8_LDA
#undef PG8_LDB
#undef PG8_MMA
#undef PG8_WAIT_V
#undef PG8_WAIT_L
#undef PG8_BAR
#undef PG8_SCHED
}

}

namespace att {
constexpr int LD = DM;
constexpr int SHM_KV = 16384;
#define KSWZ(row, colB) ((row) * 256 + ((colB) ^ (((row) & 7) << 4)))
#define SBAR() __builtin_amdgcn_sched_barrier(0)
__device__ __forceinline__ int crow(int r, int hi) { return (r & 3) + 8 * (r >> 2) + 4 * hi; }
__device__ __forceinline__ void qkt(f32x16& p0, f32x16& p1, const char* Ks, const bf16x8* qr, int r32, int hi) {
    p0 = f32x16{}; p1 = f32x16{};
#pragma unroll
    for (int d0 = 0; d0 < 8; ++d0) { const int cb = (d0 * 16 + hi * 8) * 2;
        const bf16x8 b0 = *reinterpret_cast<const bf16x8*>(Ks + KSWZ(r32, cb));
        const bf16x8 b1 = *reinterpret_cast<const bf16x8*>(Ks + KSWZ(32 + r32, cb));
        p0 = __builtin_amdgcn_mfma_f32_32x32x16_bf16(b0, qr[d0], p0, 0, 0, 0);
        p1 = __builtin_amdgcn_mfma_f32_32x32x16_bf16(b1, qr[d0], p1, 0, 0, 0); }
}
__device__ __forceinline__ int v_st(int k, int c) { const int kk = (k & ~0xC) | ((k & 4) << 1) | ((k & 8) >> 1); return ((kk >> 3) * 4 + (c >> 5)) * 512 + ((kk & 7) * 32 + (c & 31)) * 2; }
__device__ __forceinline__ int v_rd_base(int lane) { return ((lane & 3) << 3) | (((lane >> 2) & 3) << 6) | (((lane >> 4) & 1) << 5) | (((lane >> 5) & 1) << 8); }
constexpr int v_rd_off(int d0, int ks, int half) { return d0 * 512 + ks * 4096 + half * 2048; }
typedef short v4i16_t __attribute__((ext_vector_type(4)));
template <int OFF> __device__ __forceinline__ s16x4 tr_read(int vb) {
    return __builtin_bit_cast(s16x4, __builtin_amdgcn_ds_read_tr16_b64_v4i16((LAS v4i16_t*)(unsigned)(vb + OFF)));
}
template <int D0> __device__ __forceinline__ void pv_one(f32x16& od, int vb, bf16x8 pa0, bf16x8 pa1, bf16x8 pa2, bf16x8 pa3) {
    const s16x4 l0 = tr_read<v_rd_off(D0, 0, 0)>(vb), h0 = tr_read<v_rd_off(D0, 0, 1)>(vb), l1 = tr_read<v_rd_off(D0, 1, 0)>(vb), h1 = tr_read<v_rd_off(D0, 1, 1)>(vb);
    const s16x4 l2 = tr_read<v_rd_off(D0, 2, 0)>(vb), h2 = tr_read<v_rd_off(D0, 2, 1)>(vb), l3 = tr_read<v_rd_off(D0, 3, 0)>(vb), h3 = tr_read<v_rd_off(D0, 3, 1)>(vb);
#define PK(L, H) (bf16x8){L[0], L[1], L[2], L[3], H[0], H[1], H[2], H[3]}
    od = __builtin_amdgcn_mfma_f32_32x32x16_bf16(PK(l0, h0), pa0, od, 0, 0, 0);
    od = __builtin_amdgcn_mfma_f32_32x32x16_bf16(PK(l1, h1), pa1, od, 0, 0, 0);
    od = __builtin_amdgcn_mfma_f32_32x32x16_bf16(PK(l2, h2), pa2, od, 0, 0, 0);
    od = __builtin_amdgcn_mfma_f32_32x32x16_bf16(PK(l3, h3), pa3, od, 0, 0, 0);
#undef PK
}
__device__ __forceinline__ void pv_d0(f32x16* o, int vb, bf16x8 pa0, bf16x8 pa1, bf16x8 pa2, bf16x8 pa3) {
    pv_one<0>(o[0], vb, pa0, pa1, pa2, pa3); pv_one<1>(o[1], vb, pa0, pa1, pa2, pa3); pv_one<2>(o[2], vb, pa0, pa1, pa2, pa3); pv_one<3>(o[3], vb, pa0, pa1, pa2, pa3);
}
__device__ __forceinline__ void sb_scan(f32x16& p0, f32x16& p1, float& C, int hi) {
#pragma unroll
    for (int r = 0; r < 16; ++r) { p0[r] = __builtin_amdgcn_rcpf(1.0f + __builtin_amdgcn_exp2f(p0[r])); p1[r] = __builtin_amdgcn_rcpf(1.0f + __builtin_amdgcn_exp2f(p1[r])); }
    float gl[8], gh[8];
#pragma unroll
    for (int G = 0; G < 4; ++G) {
        const float g0 = (p0[4 * G] * p0[4 * G + 1]) * (p0[4 * G + 2] * p0[4 * G + 3]), g1 = (p1[4 * G] * p1[4 * G + 1]) * (p1[4 * G + 2] * p1[4 * G + 3]);
        auto r0 = __builtin_amdgcn_permlane32_swap(__float_as_uint(g0), __float_as_uint(g0), false, false);
        auto r1 = __builtin_amdgcn_permlane32_swap(__float_as_uint(g1), __float_as_uint(g1), false, false);
        gl[G] = __uint_as_float(r0[0]); gh[G] = __uint_as_float(r0[1]); gl[4 + G] = __uint_as_float(r1[0]); gh[4 + G] = __uint_as_float(r1[1]);
    }
    float E = C;
#pragma unroll
    for (int G = 3; G >= 0; --G) {
        float X = E * (hi ? 1.0f : gh[4 + G]);
#pragma unroll
        for (int i = 3; i >= 0; --i) { const float Pn = p1[4 * G + i] * X; p1[4 * G + i] = X - Pn; X = Pn; }
        E = E * (gl[4 + G] * gh[4 + G]);
    }
#pragma unroll
    for (int G = 3; G >= 0; --G) {
        float X = E * (hi ? 1.0f : gh[G]);
#pragma unroll
        for (int i = 3; i >= 0; --i) { const float Pn = p0[4 * G + i] * X; p0[4 * G + i] = X - Pn; X = Pn; }
        E = E * (gl[G] * gh[G]);
    }
    C = E;
}
__device__ __forceinline__ void attn_unit(int b, int h, int qb, const bf16_t* Q, const bf16_t* __restrict__ K, const bf16_t* __restrict__ V, bf16_t* O, char* shm) {
    int tid_ = threadIdx.x; asm volatile("" : "+v"(tid_));
    const int tid = tid_, lane = tid & 63, r32 = lane & 31, hi = lane >> 5; const int wid = __builtin_amdgcn_readfirstlane(tid >> 6);
    const long rowbase = (long)b * SEQ; const int q0w = qb * 256 + wid * 32;
    const bf16_t* Qw = Q + (rowbase + q0w + r32) * LD + h * HD + hi * 8;
    const bf16_t* Kh = K + rowbase * LD + h * HD; const bf16_t* Vh = V + rowbase * LD + h * HD;
    char* V_lds = shm; char* K_lds = shm + 2 * SHM_KV;
    bf16x8 qr[8];
#pragma unroll
    for (int d0 = 0; d0 < 8; ++d0) qr[d0] = *reinterpret_cast<const bf16x8*>(Qw + d0 * 16);
    f32x16 o[4]; o[0] = f32x16{}; o[1] = f32x16{}; o[2] = f32x16{}; o[3] = f32x16{};
    float C = 1.0f;
    const int sr = tid >> 4, sc = (tid & 15) * 8;
    const int vst0 = v_st(sr, sc), vst1 = v_st(32 + sr, sc), kst0 = KSWZ(sr, sc * 2), kst1 = KSWZ(32 + sr, sc * 2);
    const int vb0 = (int)(unsigned)(uintptr_t)V_lds + v_rd_base(lane);
    bf16x8 vs0, vs1, ks0, ks1;
#define SLOAD(k0) do { vs0 = *reinterpret_cast<const bf16x8*>(Vh + (long)((k0) + sr) * LD + sc); vs1 = *reinterpret_cast<const bf16x8*>(Vh + (long)((k0) + 32 + sr) * LD + sc); \
        ks0 = *reinterpret_cast<const bf16x8*>(Kh + (long)((k0) + sr) * LD + sc); ks1 = *reinterpret_cast<const bf16x8*>(Kh + (long)((k0) + 32 + sr) * LD + sc); } while (0)
#define SWRITE(bs) do { *reinterpret_cast<bf16x8*>(V_lds + (bs) * SHM_KV + vst0) = vs0; *reinterpret_cast<bf16x8*>(V_lds + (bs) * SHM_KV + vst1) = vs1; \
        *reinterpret_cast<bf16x8*>(K_lds + (bs) * SHM_KV + kst0) = ks0; *reinterpret_cast<bf16x8*>(K_lds + (bs) * SHM_KV + kst1) = ks1; } while (0)
    const int NT = 4 * qb + 4;
    unsigned* flags = reinterpret_cast<unsigned*>(shm + 4 * SHM_KV);
    bool wdone = false;
    SLOAD((NT - 1) * 64); SWRITE(0); __syncthreads();
    int cur = 0;
    for (int jt = NT - 1; jt >= 0; --jt) {
        if (jt > 0) SLOAD((jt - 1) * 64);
        const int k0 = jt * 64;
        if (k0 < q0w + 32 && !wdone) {
            f32x16 p0, p1;
            qkt(p0, p1, K_lds + cur * SHM_KV, qr, r32, hi);
            if (k0 + 64 > q0w) {
                const int trel = q0w + r32 - k0;
#pragma unroll
                for (int r = 0; r < 16; ++r) { const int kv = (r & 3) + 8 * (r >> 2) + 4 * hi; if (kv >= trel) p0[r] = -1e30f; if (kv + 32 >= trel) p1[r] = -1e30f; }
            }
            sb_scan(p0, p1, C, hi);
            bf16x8 pa0, pa1, pa2, pa3;
#define PK4(P, BASE, OUT) do { unsigned a0 = cvt_pk_bf16(P[BASE + 0], P[BASE + 1]), a1 = cvt_pk_bf16(P[BASE + 2], P[BASE + 3]);   \
    unsigned b0 = cvt_pk_bf16(P[BASE + 4], P[BASE + 5]), b1 = cvt_pk_bf16(P[BASE + 6], P[BASE + 7]);                              \
    auto r0 = __builtin_amdgcn_permlane32_swap(a0, b0, false, false); auto r1 = __builtin_amdgcn_permlane32_swap(a1, b1, false, false); \
    u32x4 w = {r0[0], r1[0], r0[1], r1[1]}; OUT = *reinterpret_cast<bf16x8*>(&w); } while (0)
            PK4(p0, 0, pa0); PK4(p0, 8, pa1); PK4(p1, 0, pa2); PK4(p1, 8, pa3);
#undef PK4
            pv_d0(o, vb0 + cur * SHM_KV, pa0, pa1, pa2, pa3);
            wdone = __all(C == 0.0f) != 0;
        }
        if (lane == 0) flags[(jt & 1) * 8 + wid] = wdone ? 1u : 0u;
        if (jt > 0) SWRITE(cur ^ 1);
        __syncthreads();
        cur ^= 1;
        const u32x4 f0 = *reinterpret_cast<const u32x4*>(flags + (jt & 1) * 8), f1 = *reinterpret_cast<const u32x4*>(flags + (jt & 1) * 8 + 4);
        if (__builtin_amdgcn_readfirstlane((int)(f0.x & f0.y & f0.z & f0.w & f1.x & f1.y & f1.z & f1.w)) != 0) break;
    }
    bf16_t* Ow = O + (rowbase + q0w + r32) * LD + h * HD + 4 * hi;
#pragma unroll
    for (int d0 = 0; d0 < 4; ++d0)
#pragma unroll
        for (int g = 0; g < 4; ++g) { u32x2 w; w.x = cvt_pk_bf16(o[d0][4 * g], o[d0][4 * g + 1]); w.y = cvt_pk_bf16(o[d0][4 * g + 2], o[d0][4 * g + 3]); *reinterpret_cast<u32x2*>(Ow + 32 * d0 + 8 * g) = w; }
#undef SLOAD
#undef SWRITE
}
}


__device__ __forceinline__ void p0_transpose_item(const float* __restrict__ W, int K, int N, bf16_t* __restrict__ WT, int row_off, const float* __restrict__ gain, LAS float* scr, int item, int lane) {
    const int nblk = N / 64, kb = item / nblk, nb = item % nblk, k0 = 64 * kb, n0 = 64 * nb;
    const int q = lane >> 4, m4 = (lane & 15) * 4;
    const float* src = W + (size_t)(k0 + q) * N + n0 + m4;
    f32x4 v[16];
#pragma unroll
    for (int i = 0; i < 16; ++i) v[i] = *(const f32x4*)(src + (size_t)(4 * i) * N);
    if (gain) {
#pragma unroll
        for (int i = 0; i < 16; ++i) v[i] = v[i] * gain[k0 + 4 * i + q];
    }
#pragma unroll
    for (int i = 0; i < 16; ++i)
#pragma unroll
        for (int j = 0; j < 4; ++j) scr[(m4 + j) * 65 + 4 * i + q] = v[i][j];
    LDS_WAIT(); asm volatile("" ::: "memory");
    const int c = lane & 7, nr = lane >> 3;
#pragma unroll
    for (int j = 0; j < 8; ++j) { const int n = nr + 8 * j; const LAS float* s = scr + n * 65 + 8 * c;
        u32x4 o; o.x = cvt_pk_bf16(s[0], s[1]); o.y = cvt_pk_bf16(s[2], s[3]); o.z = cvt_pk_bf16(s[4], s[5]); o.w = cvt_pk_bf16(s[6], s[7]);
        *(u32x4*)(WT + (size_t)(row_off + n0 + n) * K + k0 + 8 * c) = o; }
    LDS_WAIT(); asm volatile("" ::: "memory");
}
__device__ __forceinline__ void p0_diff_item(const float* __restrict__ x, bf16_t* __restrict__ diff, LAS float* rs, int T, int tid, int lane, int wave) {
    const int b = T >> 6, t0 = (T & 63) << 6; const long rb = (long)b * SEQ;
    for (int jj = 0; jj < 10; jj += 2) {
        const int i0 = wave + 8 * jj, i1 = i0 + 8, ta = t0 - 16 + i0, tb = t0 - 16 + i1;
        const f32x4* xa = (const f32x4*)(x + (rb + (ta > 0 ? ta : 0)) * DM) + lane; const f32x4* xb = (const f32x4*)(x + (rb + (tb > 0 ? tb : 0)) * DM) + lane;
        f32x4 va[8], vb[8];
#pragma unroll
        for (int j = 0; j < 8; ++j) { va[j] = xa[64 * j]; vb[j] = xb[64 * j]; }
        float sa = 0.f, sb = 0.f;
#pragma unroll
        for (int j = 0; j < 8; ++j) { sa += (va[j][0] * va[j][0] + va[j][1] * va[j][1]) + (va[j][2] * va[j][2] + va[j][3] * va[j][3]); sb += (vb[j][0] * vb[j][0] + vb[j][1] * vb[j][1]) + (vb[j][2] * vb[j][2] + vb[j][3] * vb[j][3]); }
        sa = wave_sum(sa); sb = wave_sum(sb);
        const float ra = ta >= 0 ? __builtin_amdgcn_rsqf(sa * (1.0f / DM) + EPS) : 0.f, rbv = tb >= 0 ? __builtin_amdgcn_rsqf(sb * (1.0f / DM) + EPS) : 0.f;
        if (lane == 0) { rs[i0] = ra; rs[i1] = rbv; }
    }
    __syncthreads();
    const int w = 2 << (wave >> 1);
    f32x4 h[16];
#pragma unroll
    for (int k = 0; k < 16; ++k) h[k] = (f32x4){0.f, 0.f, 0.f, 0.f};
    const float* xc = x + rb * DM + 4 * tid;
    for (int i8 = 0; i8 < 80; i8 += 8) {
        f32x4 v[8];
#pragma unroll
        for (int u = 0; u < 8; ++u) { const int t = t0 - 16 + i8 + u; v[u] = *(const f32x4*)(xc + (long)(t > 0 ? t : 0) * DM); }
#pragma unroll
        for (int u = 0; u < 8; ++u) {
            const int i = i8 + u, t = t0 - 16 + i;
#pragma unroll
            for (int k = 15; k >= 1; --k) h[k] = h[k - 1];
            h[0] = v[u] * rs[i];
            if (i8 >= 16) {
                f32x4 S = h[0] + h[1];
                if (w >= 4) S += h[2] + h[3];
                if (w >= 8) S += (h[4] + h[5]) + (h[6] + h[7]);
                if (w >= 16) S += ((h[8] + h[9]) + (h[10] + h[11])) + ((h[12] + h[13]) + (h[14] + h[15]));
                const int cnt = (t + 1 < w) ? (t + 1) : w; const float inv = 1.0f / (float)cnt;
                const f32x4 d = S * inv - h[0];
                u32x2 o; o.x = cvt_pk_bf16(d[0], d[1]); o.y = cvt_pk_bf16(d[2], d[3]);
                *(u32x2*)(diff + (rb + t) * DM + 4 * tid) = o;
            }
        }
    }
    __syncthreads();
}


#define XB_TMO      128
#define XB_XCNT(j)  (256  + 64 * (j))
#define XB_XSUB(j)  (1280 + 64 * (j))
#define XB_XGEN(j)  (2304 + 64 * (j))
#define XB_TOP      3328
#define XB_TOPGEN   3392
#define XCD_BAR_WORDS 3456
#define XB_SPIN_CAP (1u << 18)
__device__ __forceinline__ unsigned xb_ld(unsigned* p)              { return __hip_atomic_load(p, __ATOMIC_RELAXED, __HIP_MEMORY_SCOPE_AGENT); }
__device__ __forceinline__ unsigned xb_add(unsigned* p, unsigned v) { return __hip_atomic_fetch_add(p, v, __ATOMIC_RELAXED, __HIP_MEMORY_SCOPE_AGENT); }
__device__ __forceinline__ unsigned xb_xcc_id() { return (unsigned)__builtin_amdgcn_s_getreg((3 << 11) | 20) & 0xFu; }
#define XB_SPIN(cond, bar) do { unsigned _sp = 0; while (cond) { __builtin_amdgcn_s_sleep(1); \
    if ((++_sp & 255u) == 0u) { if (xb_ld(&(bar)[XB_TMO])) break; if (_sp > XB_SPIN_CAP) { atomicAdd(&(bar)[XB_TMO], 1u); break; } } } } while (0)
struct XcdBarrier { unsigned* bar; unsigned x; volatile LAS unsigned* st; };
__device__ __forceinline__ XcdBarrier xcd_barrier_post(unsigned* bar, volatile LAS unsigned* st) {
    XcdBarrier b; b.bar = bar; b.x = xb_xcc_id(); b.st = st;
    if (threadIdx.x == 0) (void)xb_add(&bar[XB_XCNT(b.x)], 1u);
    return b;
}
__device__ __forceinline__ void xcd_barrier_complete(unsigned* bar, unsigned x, unsigned& nloc, unsigned& nx) {
    const unsigned G = gridDim.x * gridDim.y * gridDim.z;
    unsigned sum, cnt, mine, sp = 0u;
    for (;;) {
        sum = 0u; cnt = 0u; mine = 0u;
#pragma unroll
        for (unsigned j = 0; j < 16; ++j) { const unsigned c = xb_ld(&bar[XB_XCNT(j)]); sum += c; cnt += (c > 0u) ? 1u : 0u; mine = (j == x) ? c : mine; }
        if (sum == G) break;
        __builtin_amdgcn_s_sleep(1);
        if ((++sp & 255u) == 0u) { if (xb_ld(&bar[XB_TMO])) break; if (sp > XB_SPIN_CAP) { atomicAdd(&bar[XB_TMO], 1u); break; } }
    }
    nloc = mine > 0u ? mine : 1u; nx = cnt > 0u ? cnt : 1u;
}
__device__ __forceinline__ void xcd_barrier(const XcdBarrier& b) {
    asm volatile("s_waitcnt vmcnt(0)" ::: "memory");
    __syncthreads();
    if (threadIdx.x == 0) {
        unsigned* bar = b.bar;
        __builtin_amdgcn_s_waitcnt(0);
        unsigned nloc = b.st[0], nx = b.st[1];
        if (nloc == 0u) { xcd_barrier_complete(bar, b.x, nloc, nx); b.st[0] = nloc; b.st[1] = nx; }
        const unsigned old = xb_add(&bar[XB_XSUB(b.x)], 1u);
        const unsigned gen = old / nloc;
        if (old + 1u == (gen + 1u) * nloc) {
            __builtin_amdgcn_fence(__ATOMIC_RELEASE, "agent");
            asm volatile("s_waitcnt vmcnt(0)" ::: "memory");
            const unsigned og = xb_add(&bar[XB_TOP], 1u);
            const unsigned tg = og / nx;
            if (og + 1u == (tg + 1u) * nx) xb_add(&bar[XB_TOPGEN], 1u);
            else XB_SPIN(xb_ld(&bar[XB_TOPGEN]) == tg, bar);
            __builtin_amdgcn_fence(__ATOMIC_ACQUIRE, "agent");
            xb_add(&bar[XB_XGEN(b.x)], 1u);
            asm volatile("s_waitcnt vmcnt(0)" ::: "memory");
        } else {
            XB_SPIN(xb_ld(&bar[XB_XGEN(b.x)]) == gen, bar);
            __builtin_amdgcn_fence(__ATOMIC_ACQUIRE, "agent");
            asm volatile("s_waitcnt vmcnt(0)" ::: "memory");
        }
    }
    __syncthreads();
}

struct Args { const float* in[13]; float* out; unsigned char* ws; };
__global__ void __launch_bounds__(512, 2) fwd_megakernel(Args args) {
    extern __shared__ __attribute__((aligned(16))) unsigned char lds_raw[];
    cg::grid_group grid = cg::this_grid();
    LAS unsigned char* lds = (LAS unsigned char*)lds_raw;
    const int tid = threadIdx.x, lane = tid & 63, wave = __builtin_amdgcn_readfirstlane(tid >> 6), G = gridDim.x, bid = blockIdx.x;
    const float* x = args.in[0]; const float* pool_norm = args.in[1]; const float* pool_w = args.in[2]; const float* pool_scale = args.in[3];
    const float* kv_norm = args.in[4]; const float* w_kv = args.in[5]; const float* attn_norm = args.in[6]; const float* w_q = args.in[7]; const float* w_o = args.in[8];
    const float* mlp_norm = args.in[9]; const float* w_up = args.in[10]; const float* w_down = args.in[11]; const float* final_norm = args.in[12];
    float* out = args.out; unsigned char* ws = args.ws;
    bf16_t* PWT = (bf16_t*)(ws + WS_PWT); bf16_t* WUPT = (bf16_t*)(ws + WS_WUPT); bf16_t* WDT = (bf16_t*)(ws + WS_WDT); bf16_t* WKVQT = (bf16_t*)(ws + WS_WKVQT); bf16_t* WOT = (bf16_t*)(ws + WS_WOT);
    float* SSQ = (float*)(ws + WS_SSQ); bf16_t* XB = (bf16_t*)(ws + WS_XB); bf16_t* HB = (bf16_t*)(ws + WS_H); bf16_t* DIFF = (bf16_t*)(ws + WS_DIFF);
    bf16_t* KB = (bf16_t*)(ws + WS_K); bf16_t* VB = (bf16_t*)(ws + WS_V); bf16_t* QB = (bf16_t*)(ws + WS_Q); bf16_t* OB = (bf16_t*)(ws + WS_O);

    unsigned* barw = (unsigned*)(ws + WS_BAR);
    volatile LAS unsigned* bst = (volatile LAS unsigned*)(lds + LDS_BYTES - 64);
    if (tid < 2) bst[tid] = 0u;
    __syncthreads();
    if (args.ws == nullptr) grid.sync();
    const XcdBarrier xbar = xcd_barrier_post(barw, bst);
#ifndef PROBE
#define PROBE 0
#endif
    for (int rep = 0; rep < (PROBE == 1 ? 2 : 1); ++rep) {
    for (int i = bid * 512 + tid; i < 4 * M; i += G * 512) SSQ[i] = 0.f;
    {
        LAS float* scr = (LAS float*)(lds + wave * 16896);
        const int gw = bid * 8 + wave, NGW = G * 8;
        constexpr int I_P = (512 / 64) * (512 / 64), I_UP = (DM / 64) * (FF / 64), I_DN = (FF / 64) * (DM / 64), I_KV = (DM / 64) * (2 * DM / 64), I_Q = (DM / 64) * (DM / 64);
        constexpr int NITEMS = 4 * I_P + 2 * I_UP + 2 * I_DN + I_KV + 2 * I_Q;
        for (int rep3 = 0; rep3 < (PROBE == 5 ? 2 : 1); ++rep3)
        for (int it = gw; it < NITEMS; it += NGW) {
            int r = it;
            if (r < 2 * I_UP) { const int l = r / I_UP; p0_transpose_item(w_up + (size_t)l * DM * FF, DM, FF, WUPT + (size_t)l * DM * FF, 0, mlp_norm + l * DM, scr, r % I_UP, lane); continue; } r -= 2 * I_UP;
            if (r < 2 * I_DN) { const int l = r / I_DN; p0_transpose_item(w_down + (size_t)l * DM * FF, FF, DM, WDT + (size_t)l * DM * FF, 0, nullptr, scr, r % I_DN, lane); continue; } r -= 2 * I_DN;
            if (r < I_KV) { p0_transpose_item(w_kv, DM, 2 * DM, WKVQT, 0, kv_norm, scr, r, lane); continue; } r -= I_KV;
            if (r < I_Q) { p0_transpose_item(w_q, DM, DM, WKVQT, 2 * DM, attn_norm, scr, r, lane); continue; } r -= I_Q;
            if (r < I_Q) { p0_transpose_item(w_o, DM, DM, WOT, 0, nullptr, scr, r, lane); continue; } r -= I_Q;
            { const int g = r / I_P; p0_transpose_item(pool_w + (size_t)g * 512 * 512, 512, 512, PWT, g * 512, pool_norm + g * 512, scr, r % I_P, lane); }
        }
    }
    __syncthreads();
    for (int rep2 = 0; rep2 < (PROBE == 4 ? 2 : 1); ++rep2)
    for (int T = bid; T < M / 64; T += G) p0_diff_item(x, DIFF, (LAS float*)(lds + 140000), T, tid, lane, wave);
    }
    xcd_barrier(xbar);

    {
        pg8::Gemm g{DIFF, PWT, M, DM, 512, DM, 1, 512}; pg8::StaticOrder S; S.init(M, DM, G, bid, 4);
        pg8::EpiRes<true> E{x, XB, pool_scale, SSQ, nullptr};
        pg8::gemm_phase<pg8::EpiRes<true>, pg8::StaticOrder, true, true>(lds, g, S, E);
    }
    xcd_barrier(xbar);
    for (int rep = 0; rep < (PROBE == 2 ? 2 : 1); ++rep) {
        pg8::Gemm g{XB, WUPT, M, FF, DM, DM, 0, 0}; pg8::StaticOrder S; S.init(M, FF, G, bid, 2);
        pg8::EpiUp E{HB};
        pg8::gemm_phase<pg8::EpiUp, pg8::StaticOrder, true, true>(lds, g, S, E);
    }
    xcd_barrier(xbar);
    {
        pg8::Gemm g{HB, WDT, M, DM, FF, FF, 0, 0}; pg8::StaticOrder S; S.init(M, DM, G, bid, 4);
        pg8::EpiRes<false> E{nullptr, XB, nullptr, SSQ + M, SSQ};
        pg8::gemm_phase<pg8::EpiRes<false>, pg8::StaticOrder, true, true>(lds, g, S, E);
    }
    xcd_barrier(xbar);
    {
        pg8::Gemm g{XB, WKVQT, M, 3 * DM, DM, DM, 0, 0}; pg8::StaticOrder S; S.init(M, 3 * DM, G, bid, 2);
        pg8::EpiKVQ E{SSQ + M, KB};
        pg8::gemm_phase<pg8::EpiKVQ, pg8::StaticOrder, true, true>(lds, g, S, E);
    }
    xcd_barrier(xbar);
    {
        for (int rep = 0; rep < (PROBE == 3 ? 2 : 1); ++rep)
        for (int L = bid; L < NBATCH * NH * 16; L += G) {
            const int c = L & 255, i = L >> 8, bh = c >> 2, j = c & 3;
            const int qb = (i == 0) ? 15 - j : (i == 1) ? 8 + j : (i == 2) ? 7 - j : j;
            att::attn_unit(bh >> 4, bh & 15, qb, QB, KB, VB, OB, (char*)lds_raw);
        }
    }
    xcd_barrier(xbar);
    {
        pg8::Gemm g{OB, WOT, M, DM, DM, DM, 0, 0}; pg8::StaticOrder S; S.init(M, DM, G, bid, 4);
        pg8::EpiRes<false> E{nullptr, XB, nullptr, SSQ + 2 * M, nullptr};
        pg8::gemm_phase<pg8::EpiRes<false>, pg8::StaticOrder, true, true>(lds, g, S, E);
    }
    xcd_barrier(xbar);
    {
        pg8::Gemm g{XB, WUPT + (size_t)DM * FF, M, FF, DM, DM, 0, 0}; pg8::StaticOrder S; S.init(M, FF, G, bid, 2);
        pg8::EpiUp E{HB};
        pg8::gemm_phase<pg8::EpiUp, pg8::StaticOrder, true, true>(lds, g, S, E);
    }
    xcd_barrier(xbar);
    if (G == 256) {
        pg8::Gemm g{HB, WDT + (size_t)DM * FF, M, DM, FF, FF, 0, 0}; pg8::StaticOrder S; S.init(M, DM, G, bid, 4);
        pg8::EpiFinal E{XB, SSQ + 2 * M, SSQ + 3 * M, barw + XCD_BAR_WORDS, final_norm, out};
        pg8::gemm_phase<pg8::EpiFinal, pg8::StaticOrder, true, true>(lds, g, S, E);
    } else {
        {
            pg8::Gemm g{HB, WDT + (size_t)DM * FF, M, DM, FF, FF, 0, 0}; pg8::StaticOrder S; S.init(M, DM, G, bid, 4);
            pg8::EpiRes<false> E{nullptr, XB, nullptr, SSQ + 3 * M, SSQ + 2 * M};
            pg8::gemm_phase<pg8::EpiRes<false>, pg8::StaticOrder, true, true>(lds, g, S, E);
        }
        xcd_barrier(xbar);
        const float* ssq = SSQ + 3 * M;
        for (int m = bid * 8 + wave; m < M; m += G * 8) {
            const float rstd = __builtin_amdgcn_rsqf(ssq[m] * (1.0f / DM) + EPS);
            const u32x4* xr = (const u32x4*)(XB + (size_t)m * DM) + lane; f32x4* orow = (f32x4*)(out + (size_t)m * DM) + 2 * lane; const f32x4* gr = (const f32x4*)final_norm + 2 * lane;
#pragma unroll
            for (int j = 0; j < 4; ++j) {
                const u32x4 q = xr[64 * j];
                const f32x4 a = (f32x4){__uint_as_float(q.x << 16), __uint_as_float(q.x & 0xffff0000u), __uint_as_float(q.y << 16), __uint_as_float(q.y & 0xffff0000u)};
                const f32x4 b = (f32x4){__uint_as_float(q.z << 16), __uint_as_float(q.z & 0xffff0000u), __uint_as_float(q.w << 16), __uint_as_float(q.w & 0xffff0000u)};
                orow[128 * j] = a * rstd * gr[128 * j]; orow[128 * j + 1] = b * rstd * gr[128 * j + 1];
            }
        }
    }
}

extern "C" void kernel_launch(void* const* d_in, const int* in_sizes, int n_in, void* d_out, int out_size, void* d_ws, size_t ws_size, hipStream_t stream) {
    static int grid = 0;
    if (grid == 0) {
        if (n_in != 13 || in_sizes[0] != M * DM || out_size != M * DM || ws_size < WS_END) { fprintf(stderr, "kernel_launch: unexpected shapes: n_in %d in0 %d out %d ws %zu (need %zu)\n", n_in, n_in > 0 ? in_sizes[0] : -1, out_size, ws_size, (size_t)WS_END); grid = -1; return; }
        int dev = 0, cus = 0, per_cu = 0;
        if (hipGetDevice(&dev) != hipSuccess || hipDeviceGetAttribute(&cus, hipDeviceAttributeMultiprocessorCount, dev) != hipSuccess) { fprintf(stderr, "kernel_launch: device query failed\n"); grid = -1; return; }
        if (hipFuncSetAttribute((const void*)fwd_megakernel, hipFuncAttributeMaxDynamicSharedMemorySize, LDS_BYTES) != hipSuccess) { fprintf(stderr, "kernel_launch: hipFuncSetAttribute failed\n"); grid = -1; return; }
        if (hipOccupancyMaxActiveBlocksPerMultiprocessor(&per_cu, (const void*)fwd_megakernel, 512, LDS_BYTES) != hipSuccess || per_cu < 1) { fprintf(stderr, "kernel_launch: occupancy query gave %d\n", per_cu); per_cu = 1; }
        (void)hipGetLastError();
        grid = cus * per_cu;
    }
    if (grid < 0) return;
    if (hipMemsetAsync((char*)d_ws + WS_BAR, 0, (XCD_BAR_WORDS + 64 * 64) * sizeof(unsigned), stream) != hipSuccess) { fprintf(stderr, "kernel_launch: hipMemsetAsync of the barrier words failed; nothing launched\n"); return; }
    Args a{};
    for (int i = 0; i < 13; ++i) a.in[i] = (const float*)d_in[i];
    a.out = (float*)d_out; a.ws = (unsigned char*)d_ws;
    void* kargs[] = {&a};
    hipError_t e = hipLaunchCooperativeKernel((const void*)fwd_megakernel, dim3(grid), dim3(512), kargs, LDS_BYTES, stream);
    if (e != hipSuccess) fprintf(stderr, "kernel_launch: cooperative launch failed: %s (grid %d)\n", hipGetErrorString(e), grid);
}
```

```cpp
#define PROBE 0
#include <hip/hip_runtime.h>
#include <hip/hip_cooperative_groups.h>
#include <cstdio>
#include <cstdint>
namespace cg = cooperative_groups;

#define LAS __attribute__((address_space(3)))
typedef unsigned short bf16_t;
typedef short bf16x8 __attribute__((ext_vector_type(8)));
typedef short s16x4 __attribute__((ext_vector_type(4)));
typedef float f32x4 __attribute__((ext_vector_type(4)));
typedef float f32x16 __attribute__((ext_vector_type(16)));
typedef unsigned u32x4 __attribute__((ext_vector_type(4)));
typedef unsigned u32x2 __attribute__((ext_vector_type(2)));

constexpr int DM = 2048, NBATCH = 4, SEQ = 4096, M = NBATCH * SEQ, FF = 8192, NH = 16, HD = 128;
constexpr float EPS = 1e-6f;
constexpr float C2 = 0.08838834764831845f * 1.4426950408889634f;

constexpr size_t MiB = 1u << 20;
constexpr size_t WS_PWT = 0;
constexpr size_t WS_WUPT = 2 * MiB;
constexpr size_t WS_WDT = 66 * MiB;
constexpr size_t WS_WKVQT = 130 * MiB;
constexpr size_t WS_WOT = 154 * MiB;
constexpr size_t WS_SSQ = 162 * MiB;
constexpr size_t WS_BAR = 162 * MiB + 512 * 1024;
constexpr size_t WS_XB = 163 * MiB;
constexpr size_t WS_H = 227 * MiB;
constexpr size_t WS_DIFF = WS_H, WS_K = WS_H, WS_V = WS_H + 64 * MiB, WS_Q = WS_H + 128 * MiB, WS_O = WS_H + 192 * MiB;
constexpr size_t WS_END = 483 * MiB;
constexpr int LDS_BYTES = 147456;

#define LDS_WAIT() asm volatile("s_waitcnt lgkmcnt(0)" ::: "memory")
__device__ __forceinline__ unsigned f2bf(float f) { unsigned u = __builtin_bit_cast(unsigned, f); return (u + 0x7fffu + ((u >> 16) & 1u)) >> 16; }
__device__ __forceinline__ unsigned pk2(float lo, float hi) { return f2bf(lo) | (f2bf(hi) << 16); }
typedef float f32x2_t __attribute__((ext_vector_type(2))); typedef __bf16 bf16x2_t __attribute__((ext_vector_type(2)));
__device__ __forceinline__ unsigned cvt_pk_bf16(float lo, float hi) { const f32x2_t v = {lo, hi}; const bf16x2_t b = __builtin_convertvector(v, bf16x2_t); return __builtin_bit_cast(unsigned, b); }
__device__ __forceinline__ float wave_sum(float v) {
#pragma unroll
    for (int o = 1; o < 64; o <<= 1) v += __shfl_xor(v, o);
    return v;
}

namespace pg8 {
constexpr int BM = 256, BK = 64, HALF = 128, HTB = HALF * BK * 2, STAGE_BYTES = 8 * HTB, NXCD = 8, WGM = 8;
__host__ __device__ __forceinline__ int lds_byte(int r, int c) { const int st = (r >> 4) * 2 + (c >> 5), rr = r & 15, cc = c & 31, ob = rr * 64 + cc * 2; return st * 1024 + (ob ^ (((ob >> 9) & 1) << 5)); }
__host__ __device__ __forceinline__ void stage_rc(int b, int& R, int& C) { const int st = b / 1024, sb = b % 1024, swz = sb ^ (((sb >> 9) & 1) << 5); R = (st >> 1) * 16 + swz / 64; C = (st & 1) * 32 + (swz % 64) / 2; }
__host__ __device__ __forceinline__ int perm32(int rho) { const int n = rho >> 4, i = rho & 15; return 8 * (i >> 2) + 4 * n + (i & 3); }

struct Unit { int pm, pn; };
struct Gemm { const bf16_t* A; const bf16_t* Bt; int M, N, K, lda, a_shift, a_cols; };

struct StaticOrder {
    int nM, nN, nwg, G, c, wgm, rev;
    __host__ __device__ void init(int M_, int N_, int G_, int c_, int wgm_ = WGM, int rev_ = 0) { nM = M_ / BM; nN = N_ / BM; nwg = nM * nN; G = G_; c = c_; wgm = wgm_; rev = rev_; }
    __host__ __device__ bool next(int i, Unit& u) const {
        long L = (long)i * G + c; if (L >= nwg) return false;
        if (rev) L = nwg - 1 - L;
        int wgid = (int)L; { const int q = nwg / NXCD, r = nwg % NXCD, xcd = wgid % NXCD, off = wgid / NXCD; wgid = (xcd < r ? xcd * (q + 1) : r * (q + 1) + (xcd - r) * q) + off; }
        const int nig = wgm * nN, gid = wgid / nig, fm = gid * wgm, gsz = (nM - fm) < wgm ? (nM - fm) : wgm;
        u.pm = fm + ((wgid % nig) % gsz); u.pn = (wgid % nig) / gsz; return true;
    }
};


template <bool IN32> struct EpiRes {
    static constexpr bool PERM = true;
    const float* Xin32; bf16_t* XB; const float* scale; float* ssq; const float* rs_ssq;
    __device__ __forceinline__ void operator()(const f32x4 (&acc)[2][2][4][2], const Unit& u, int wr, int wc, int fr, int fq) const {
        const int row0 = u.pm * BM + wr * 64 + fr, col0 = u.pn * BM + wc * 32 + 8 * fq;
        f32x4 sv[2][2];
#pragma unroll
        for (int bj = 0; bj < 2; ++bj)
#pragma unroll
            for (int n = 0; n < 2; ++n) sv[bj][n] = scale ? *(const f32x4*)(scale + col0 + bj * HALF + 4 * n) : (f32x4){1.f, 1.f, 1.f, 1.f};
#pragma unroll
        for (int ai = 0; ai < 2; ++ai)
#pragma unroll
            for (int m = 0; m < 4; ++m) {
                const int row = row0 + ai * HALF + m * 16; const size_t ro = (size_t)row * DM + col0; float s = 0.f;
                const float rsc = rs_ssq ? __builtin_amdgcn_rcpf(rs_ssq[row] * (1.0f / DM) + EPS) : 1.0f;
#pragma unroll
                for (int bj = 0; bj < 2; ++bj) {
                    f32x4 r0, r1;
                    if constexpr (IN32) { r0 = *(const f32x4*)(Xin32 + ro + bj * HALF); r1 = *(const f32x4*)(Xin32 + ro + bj * HALF + 4); }
                    else { const u32x4 q = *(const u32x4*)(XB + ro + bj * HALF);
                        r0 = (f32x4){__uint_as_float(q.x << 16), __uint_as_float(q.x & 0xffff0000u), __uint_as_float(q.y << 16), __uint_as_float(q.y & 0xffff0000u)};
                        r1 = (f32x4){__uint_as_float(q.z << 16), __uint_as_float(q.z & 0xffff0000u), __uint_as_float(q.w << 16), __uint_as_float(q.w & 0xffff0000u)}; }
                    const f32x4 v0 = acc[ai][bj][m][0] * (sv[bj][0] * rsc) + r0, v1 = acc[ai][bj][m][1] * (sv[bj][1] * rsc) + r1;
                    u32x4 w; w.x = cvt_pk_bf16(v0[0], v0[1]); w.y = cvt_pk_bf16(v0[2], v0[3]); w.z = cvt_pk_bf16(v1[0], v1[1]); w.w = cvt_pk_bf16(v1[2], v1[3]); *(u32x4*)(XB + ro + bj * HALF) = w;
                    s += (v0[0] * v0[0] + v0[1] * v0[1]) + (v0[2] * v0[2] + v0[3] * v0[3]) + (v1[0] * v1[0] + v1[1] * v1[1]) + (v1[2] * v1[2] + v1[3] * v1[3]);
                }
                s += __shfl_xor(s, 16); s += __shfl_xor(s, 32);
                if (fq == 0) unsafeAtomicAdd(ssq + row, s);
            }
    }
};
struct EpiFinal {
    static constexpr bool PERM = true;
    const bf16_t* XB; const float* rs_ssq; float* ssq; unsigned* cnt; const float* gain; float* out;
    __device__ __forceinline__ void operator()(f32x4 (&acc)[2][2][4][2], const Unit& u, int wr, int wc, int fr, int fq) const {
        const int row0 = u.pm * BM + wr * 64 + fr, col0 = u.pn * BM + wc * 32 + 8 * fq;
#pragma unroll
        for (int ai = 0; ai < 2; ++ai)
#pragma unroll
            for (int m = 0; m < 4; ++m) {
                const int row = row0 + ai * HALF + m * 16; const size_t ro = (size_t)row * DM + col0; float s = 0.f;
                const float rsc = __builtin_amdgcn_rcpf(rs_ssq[row] * (1.0f / DM) + EPS);
#pragma unroll
                for (int bj = 0; bj < 2; ++bj) {
                    const u32x4 q = *(const u32x4*)(XB + ro + bj * HALF);
                    const f32x4 r0 = (f32x4){__uint_as_float(q.x << 16), __uint_as_float(q.x & 0xffff0000u), __uint_as_float(q.y << 16), __uint_as_float(q.y & 0xffff0000u)};
                    const f32x4 r1 = (f32x4){__uint_as_float(q.z << 16), __uint_as_float(q.z & 0xffff0000u), __uint_as_float(q.w << 16), __uint_as_float(q.w & 0xffff0000u)};
                    const f32x4 v0 = acc[ai][bj][m][0] * rsc + r0, v1 = acc[ai][bj][m][1] * rsc + r1;
                    acc[ai][bj][m][0] = v0; acc[ai][bj][m][1] = v1;
                    s += (v0[0] * v0[0] + v0[1] * v0[1]) + (v0[2] * v0[2] + v0[3] * v0[3]) + (v1[0] * v1[0] + v1[1] * v1[1]) + (v1[2] * v1[2] + v1[3] * v1[3]);
                }
                s += __shfl_xor(s, 16); s += __shfl_xor(s, 32);
                if (fq == 0) unsafeAtomicAdd(ssq + row, s);
            }
        asm volatile("s_waitcnt vmcnt(0)" ::: "memory");
        unsigned* pc = cnt + 64 * u.pm;
        if (fr == 0 && fq == 0) (void)__hip_atomic_fetch_add(pc, 1u, __ATOMIC_RELAXED, __HIP_MEMORY_SCOPE_AGENT);
        { unsigned sp = 0;
          while ((unsigned)__builtin_amdgcn_readfirstlane((int)__hip_atomic_load(pc, __ATOMIC_RELAXED, __HIP_MEMORY_SCOPE_AGENT)) < 64u) { __builtin_amdgcn_s_sleep(2); if (++sp > (1u << 22)) break; } }
        asm volatile("" ::: "memory");
#pragma unroll
        for (int ai = 0; ai < 2; ++ai)
#pragma unroll
            for (int m = 0; m < 4; ++m) {
                const int row = row0 + ai * HALF + m * 16; const size_t ro = (size_t)row * DM + col0;
                const float tot = __hip_atomic_load(ssq + row, __ATOMIC_RELAXED, __HIP_MEMORY_SCOPE_AGENT);
                const float rstd = __builtin_amdgcn_rsqf(tot * (1.0f / DM) + EPS);
#pragma unroll
                for (int bj = 0; bj < 2; ++bj) {
                    const f32x4 g0 = *(const f32x4*)(gain + col0 + bj * HALF), g1 = *(const f32x4*)(gain + col0 + bj * HALF + 4);
                    *(f32x4*)(out + ro + bj * HALF) = acc[ai][bj][m][0] * rstd * g0; *(f32x4*)(out + ro + bj * HALF + 4) = acc[ai][bj][m][1] * rstd * g1;
                }
            }
    }
};
struct EpiUp {
    static constexpr bool PERM = true;
    bf16_t* H;
    __device__ __forceinline__ void operator()(const f32x4 (&acc)[2][2][4][2], const Unit& u, int wr, int wc, int fr, int fq) const {
        const int row0 = u.pm * BM + wr * 64 + fr, col0 = u.pn * BM + wc * 32 + 8 * fq;
#pragma unroll
        for (int ai = 0; ai < 2; ++ai)
#pragma unroll
            for (int m = 0; m < 4; ++m) {
                const int row = row0 + ai * HALF + m * 16;
                bf16_t* rowp = H + (size_t)row * FF + col0;
#pragma unroll
                for (int bj = 0; bj < 2; ++bj) {
                    f32x4 v0 = acc[ai][bj][m][0], v1 = acc[ai][bj][m][1];
#pragma unroll
                    for (int j = 0; j < 4; ++j) { v0[j] = fmaxf(v0[j], 0.f); v0[j] *= v0[j]; v1[j] = fmaxf(v1[j], 0.f); v1[j] *= v1[j]; }
                    u32x4 w; w.x = cvt_pk_bf16(v0[0], v0[1]); w.y = cvt_pk_bf16(v0[2], v0[3]); w.z = cvt_pk_bf16(v1[0], v1[1]); w.w = cvt_pk_bf16(v1[2], v1[3]);
                    *(u32x4*)(rowp + bj * HALF) = w;
                }
            }
    }
};
struct EpiKVQ {
    static constexpr bool PERM = true;
    const float* ssq; bf16_t* KVQ;
    __device__ __forceinline__ void operator()(const f32x4 (&acc)[2][2][4][2], const Unit& u, int wr, int wc, int fr, int fq) const {
        const int row0 = u.pm * BM + wr * 64 + fr; int colt = u.pn * BM; const int t = colt / DM; colt -= t * DM;
        bf16_t* base = KVQ + (size_t)t * ((size_t)M * DM); const float sc = (t == 2) ? C2 : 1.0f;
        const int col0 = colt + wc * 32 + 8 * fq;
#pragma unroll
        for (int ai = 0; ai < 2; ++ai)
#pragma unroll
            for (int m = 0; m < 4; ++m) {
                const int row = row0 + ai * HALF + m * 16; const float rstd = __builtin_amdgcn_rsqf(ssq[row] * (1.0f / DM) + EPS) * sc;
                bf16_t* rowp = base + (size_t)row * DM + col0;
#pragma unroll
                for (int bj = 0; bj < 2; ++bj) {
                    const f32x4 v0 = acc[ai][bj][m][0] * rstd, v1 = acc[ai][bj][m][1] * rstd;
                    u32x4 w; w.x = cvt_pk_bf16(v0[0], v0[1]); w.y = cvt_pk_bf16(v0[2], v0[3]); w.z = cvt_pk_bf16(v1[0], v1[1]); w.w = cvt_pk_bf16(v1[2], v1[3]);
                    *(u32x4*)(rowp + bj * HALF) = w;
                }
            }
    }
};
template <class Epi, class Sched, bool ALIGN_EPI = false, bool SP2 = false>
__device__ __forceinline__ void gemm_phase(LAS unsigned char* lds, const Gemm g, const Sched& S, const Epi& E) {
    int tid_ = threadIdx.x; asm volatile("" : "+v"(tid_));
    const int tid = tid_, wid = __builtin_amdgcn_readfirstlane(tid >> 6), lane = tid & 63, wr = wid >> 2, wc = wid & 3, fr = lane & 15, fq = lane >> 4;
    const int K = g.K, nt = K / BK, lda = g.lda;
    unsigned voffA[2], voffB[2];
#pragma unroll
    for (int i = 0; i < 2; ++i) { int R, C; stage_rc(tid * 16 + i * 8192, R, C); const int Rb = Epi::PERM ? ((R & ~31) + perm32(R & 31)) : R;
        voffA[i] = (unsigned)(R * lda + C) * 2u; voffB[i] = (unsigned)(Rb * K + C) * 2u; }
    const size_t kstep = (size_t)(BK * 2);
    const size_t hstepA = (size_t)HALF * lda * 2, hstepB = (size_t)HALF * K * 2;
    const size_t tstepA = 2 * hstepA, tstepB = 2 * hstepB;
    const unsigned ldsw = (unsigned)wid * 1024u;
    const int aoff = lds_byte(wr * 64 + fr, fq * 8), boff = lds_byte(wc * 32 + fr, fq * 8);
#define PG8_SA(b, h) (((b) * 2 + (h)) * HTB)
#define PG8_SB(b, h) ((4 + (b) * 2 + (h)) * HTB)
#define PG8_STAGE(bufoff, gbase, voff) do { _Pragma("unroll") for (int _i = 0; _i < 2; ++_i) \
        __builtin_amdgcn_global_load_lds((const unsigned*)((const char*)(gbase) + (voff)[_i]), (LAS unsigned*)(lds + (bufoff) + ldsw + _i * 8192), 16, 0, 0); } while (0)
#define PG8_LDA(dst, b, h) do { _Pragma("unroll") for (int m = 0; m < 4; ++m) _Pragma("unroll") for (int k = 0; k < 2; ++k) dst[m][k] = *(const LAS bf16x8*)(lds + PG8_SA(b, h) + aoff + m * 2048 + k * 1024); } while (0)
#define PG8_LDB(dst, b, h) do { _Pragma("unroll") for (int n = 0; n < 2; ++n) _Pragma("unroll") for (int k = 0; k < 2; ++k) dst[n][k] = *(const LAS bf16x8*)(lds + PG8_SB(b, h) + boff + n * 2048 + k * 1024); } while (0)
#define PG8_MMA(ai, bj, At, Bt) do { __builtin_amdgcn_s_setprio(1); _Pragma("unroll") for (int m = 0; m < 4; ++m) _Pragma("unroll") for (int n = 0; n < 2; ++n) _Pragma("unroll") for (int k = 0; k < 2; ++k) \
        acc[ai][bj][m][n] = __builtin_amdgcn_mfma_f32_16x16x32_bf16(Bt[n][k], At[m][k], acc[ai][bj][m][n], 0, 0, 0); __builtin_amdgcn_s_setprio(0); } while (0)
#define PG8_WAIT_V(n) asm volatile("s_waitcnt vmcnt(" #n ")" ::: "memory")
#define PG8_WAIT_L(n) asm volatile("s_waitcnt lgkmcnt(" #n ")" ::: "memory")
#define PG8_BAR __builtin_amdgcn_s_barrier()
#define PG8_SCHED __builtin_amdgcn_sched_barrier(0)
    Unit cur, nxt; int ui = 0;
    if (!S.next(0, cur)) return;
    f32x4 acc[2][2][4][2];
#pragma unroll
    for (int a = 0; a < 2; ++a)
#pragma unroll
        for (int b = 0; b < 2; ++b)
#pragma unroll
            for (int m = 0; m < 4; ++m)
#pragma unroll
                for (int n = 0; n < 2; ++n) acc[a][b][m][n] = (f32x4){0.f, 0.f, 0.f, 0.f};
    bf16x8 At[4][2], B0[2][2], B1[2][2];
    const char* cA = (const char*)g.A + (size_t)cur.pm * tstepA + (size_t)((cur.pn >> g.a_shift) * g.a_cols) * 2; const char* cB = (const char*)g.Bt + (size_t)cur.pn * tstepB;
    if constexpr (SP2) {
        PG8_STAGE(PG8_SB(0, 0), cB, voffB); PG8_STAGE(PG8_SB(0, 1), cB + hstepB, voffB); PG8_STAGE(PG8_SA(0, 0), cA, voffA); PG8_STAGE(PG8_SA(0, 1), cA + hstepA, voffA);
        if (wr == 1) PG8_BAR;
        PG8_WAIT_V(2); PG8_BAR;
        PG8_STAGE(PG8_SB(1, 0), cB + kstep, voffB); PG8_STAGE(PG8_SA(1, 0), cA + kstep, voffA); PG8_STAGE(PG8_SB(1, 1), cB + hstepB + kstep, voffB);
        PG8_WAIT_V(6); PG8_BAR;
    } else {
        PG8_STAGE(PG8_SB(0, 0), cB, voffB); PG8_STAGE(PG8_SA(0, 0), cA, voffA); PG8_STAGE(PG8_SB(0, 1), cB + hstepB, voffB); PG8_STAGE(PG8_SA(0, 1), cA + hstepA, voffA);
        if (wr == 1) PG8_BAR;
        PG8_WAIT_V(4); PG8_BAR;
        PG8_STAGE(PG8_SB(1, 0), cB + kstep, voffB); PG8_STAGE(PG8_SA(1, 0), cA + kstep, voffA); PG8_STAGE(PG8_SB(1, 1), cB + hstepB + kstep, voffB);
        PG8_WAIT_V(6); PG8_BAR;
    }
    for (;;) {
        const bool has_next = S.next(ui + 1, nxt);
        const char* nA = has_next ? (const char*)g.A + (size_t)nxt.pm * tstepA + (size_t)((nxt.pn >> g.a_shift) * g.a_cols) * 2 : cA; const char* nB = has_next ? (const char*)g.Bt + (size_t)nxt.pn * tstepB : cB;
        for (int t = 0; t < nt; t += 2) {
            const bool last = (t == nt - 2);
            const char* a1 = cA + (size_t)(t + 1) * kstep;
            const char* a2 = last ? nA : cA + (size_t)(t + 2) * kstep; const char* b2 = last ? nB : cB + (size_t)(t + 2) * kstep;
            const char* a3 = a2 + kstep; const char* b3 = b2 + kstep;
            if constexpr (SP2) {
            PG8_LDB(B0, 0, 0); PG8_LDB(B1, 0, 1); PG8_SCHED; PG8_LDA(At, 0, 0); PG8_STAGE(PG8_SA(1, 1), a1 + hstepA, voffA);
            PG8_WAIT_V(8); PG8_WAIT_L(0); PG8_BAR; PG8_MMA(0, 0, At, B0); PG8_MMA(0, 1, At, B1); PG8_BAR; PG8_SCHED;
            PG8_LDA(At, 0, 1); PG8_STAGE(PG8_SB(0, 0), b2, voffB); PG8_STAGE(PG8_SB(0, 1), b2 + hstepB, voffB); PG8_STAGE(PG8_SA(0, 0), a2, voffA);
            PG8_WAIT_V(8); PG8_WAIT_L(0); PG8_BAR; PG8_MMA(1, 0, At, B0); PG8_MMA(1, 1, At, B1); PG8_BAR; PG8_SCHED;
            PG8_LDB(B0, 1, 0); PG8_LDB(B1, 1, 1); PG8_SCHED; PG8_LDA(At, 1, 0); PG8_STAGE(PG8_SA(0, 1), a2 + hstepA, voffA);
            PG8_WAIT_V(8); PG8_WAIT_L(0); PG8_BAR; PG8_MMA(0, 0, At, B0); PG8_MMA(0, 1, At, B1); PG8_BAR; PG8_SCHED;
            PG8_LDA(At, 1, 1); PG8_STAGE(PG8_SB(1, 0), b3, voffB); PG8_STAGE(PG8_SB(1, 1), b3 + hstepB, voffB); PG8_STAGE(PG8_SA(1, 0), a3, voffA);
            PG8_WAIT_V(8); PG8_WAIT_L(0); PG8_BAR; PG8_MMA(1, 0, At, B0); PG8_MMA(1, 1, At, B1); PG8_BAR; PG8_SCHED;
            } else {
            PG8_LDB(B0, 0, 0); PG8_SCHED; PG8_LDA(At, 0, 0); PG8_STAGE(PG8_SA(1, 1), a1 + hstepA, voffA);
            PG8_WAIT_L(8); PG8_BAR; PG8_WAIT_L(0); PG8_MMA(0, 0, At, B0); PG8_BAR; PG8_SCHED;
            PG8_LDB(B1, 0, 1); PG8_STAGE(PG8_SB(0, 0), b2, voffB);
            PG8_BAR; PG8_WAIT_L(0); PG8_MMA(0, 1, At, B1); PG8_BAR;
            PG8_LDA(At, 0, 1); PG8_STAGE(PG8_SA(0, 0), a2, voffA);
            PG8_BAR; PG8_WAIT_L(0); PG8_MMA(1, 0, At, B0); PG8_BAR; PG8_SCHED;
            PG8_STAGE(PG8_SB(0, 1), b2 + hstepB, voffB);
            PG8_WAIT_V(6); PG8_BAR; PG8_MMA(1, 1, At, B1); PG8_BAR;
            PG8_LDB(B0, 1, 0); PG8_SCHED; PG8_LDA(At, 1, 0); PG8_STAGE(PG8_SA(0, 1), a2 + hstepA, voffA);
            PG8_WAIT_L(8); PG8_BAR; PG8_WAIT_L(0); PG8_MMA(0, 0, At, B0); PG8_BAR; PG8_SCHED;
            PG8_LDB(B1, 1, 1); PG8_STAGE(PG8_SB(1, 0), b3, voffB);
            PG8_BAR; PG8_WAIT_L(0); PG8_MMA(0, 1, At, B1); PG8_BAR;
            PG8_LDA(At, 1, 1); PG8_STAGE(PG8_SA(1, 0), a3, voffA);
            PG8_BAR; PG8_WAIT_L(0); PG8_MMA(1, 0, At, B0); PG8_BAR; PG8_SCHED;
            PG8_STAGE(PG8_SB(1, 1), b3 + hstepB, voffB);
            PG8_WAIT_V(6); PG8_BAR; PG8_MMA(1, 1, At, B1); PG8_BAR;
            }
        }
        if constexpr (ALIGN_EPI) { if (wr == 0) PG8_BAR; }
        E(acc, cur, wr, wc, fr, fq);
        if (!has_next) break;
#pragma unroll
        for (int a = 0; a < 2; ++a)
#pragma unroll
            for (int b = 0; b < 2; ++b)
#pragma unroll
                for (int m = 0; m < 4; ++m)
#pragma unroll
                    for (int n = 0; n < 2; ++n) acc[a][b][m][n] = (f32x4){0.f, 0.f, 0.f, 0.f};
        cur = nxt; cA = nA; cB = nB; ++ui;
        if constexpr (ALIGN_EPI) { if (wr == 1) PG8_BAR; }
    }
    PG8_WAIT_V(0);
    if constexpr (!ALIGN_EPI) { if (wr == 0) PG8_BAR; }
    PG8_BAR;
#undef PG8_SA
#undef PG8_SB
#undef PG8_STAGE
#undef PG8_LDA
#undef PG8_LDB
#undef PG8_MMA
#undef PG8_WAIT_V
#undef PG8_WAIT_L
#undef PG8_BAR
#undef PG8_SCHED
}

}

namespace att {
constexpr int LD = DM;
constexpr int SHM_KV = 16384;
#define KSWZ(row, colB) ((row) * 256 + ((colB) ^ (((row) & 7) << 4)))
#define SBAR() __builtin_amdgcn_sched_barrier(0)
__device__ __forceinline__ int crow(int r, int hi) { return (r & 3) + 8 * (r >> 2) + 4 * hi; }
__device__ __forceinline__ void qkt(f32x16& p0, f32x16& p1, const char* Ks, const bf16x8* qr, int r32, int hi) {
    p0 = f32x16{}; p1 = f32x16{};
#pragma unroll
    for (int d0 = 0; d0 < 8; ++d0) { const int cb = (d0 * 16 + hi * 8) * 2;
        const bf16x8 b0 = *reinterpret_cast<const bf16x8*>(Ks + KSWZ(r32, cb));
        const bf16x8 b1 = *reinterpret_cast<const bf16x8*>(Ks + KSWZ(32 + r32, cb));
        p0 = __builtin_amdgcn_mfma_f32_32x32x16_bf16(b0, qr[d0], p0, 0, 0, 0);
        p1 = __builtin_amdgcn_mfma_f32_32x32x16_bf16(b1, qr[d0], p1, 0, 0, 0); }
}
__device__ __forceinline__ int v_st(int k, int c) { const int kk = (k & ~0xC) | ((k & 4) << 1) | ((k & 8) >> 1); return ((kk >> 3) * 4 + (c >> 5)) * 512 + ((kk & 7) * 32 + (c & 31)) * 2; }
__device__ __forceinline__ int v_rd_base(int lane) { return ((lane & 3) << 3) | (((lane >> 2) & 3) << 6) | (((lane >> 4) & 1) << 5) | (((lane >> 5) & 1) << 8); }
constexpr int v_rd_off(int d0, int ks, int half) { return d0 * 512 + ks * 4096 + half * 2048; }
template <int OFF> __device__ __forceinline__ s16x4 tr_read(int vb) {
    s16x4 r; asm volatile("ds_read_b64_tr_b16 %0, %1 offset:%2" : "=&v"(r) : "v"(vb), "i"(OFF) : "memory"); return r;
}
template <int D0> __device__ __forceinline__ void pv_one(f32x16& od, int vb, bf16x8 pa0, bf16x8 pa1, bf16x8 pa2, bf16x8 pa3) {
    const s16x4 l0 = tr_read<v_rd_off(D0, 0, 0)>(vb), h0 = tr_read<v_rd_off(D0, 0, 1)>(vb), l1 = tr_read<v_rd_off(D0, 1, 0)>(vb), h1 = tr_read<v_rd_off(D0, 1, 1)>(vb);
    const s16x4 l2 = tr_read<v_rd_off(D0, 2, 0)>(vb), h2 = tr_read<v_rd_off(D0, 2, 1)>(vb), l3 = tr_read<v_rd_off(D0, 3, 0)>(vb), h3 = tr_read<v_rd_off(D0, 3, 1)>(vb);
    asm volatile("s_waitcnt lgkmcnt(0)" ::: "memory"); SBAR();
#define PK(L, H) (bf16x8){L[0], L[1], L[2], L[3], H[0], H[1], H[2], H[3]}
    od = __builtin_amdgcn_mfma_f32_32x32x16_bf16(PK(l0, h0), pa0, od, 0, 0, 0);
    od = __builtin_amdgcn_mfma_f32_32x32x16_bf16(PK(l1, h1), pa1, od, 0, 0, 0);
    od = __builtin_amdgcn_mfma_f32_32x32x16_bf16(PK(l2, h2), pa2, od, 0, 0, 0);
    od = __builtin_amdgcn_mfma_f32_32x32x16_bf16(PK(l3, h3), pa3, od, 0, 0, 0);
#undef PK
}
__device__ __forceinline__ void pv_d0(f32x16* o, int vb, bf16x8 pa0, bf16x8 pa1, bf16x8 pa2, bf16x8 pa3) {
    pv_one<0>(o[0], vb, pa0, pa1, pa2, pa3); pv_one<1>(o[1], vb, pa0, pa1, pa2, pa3); pv_one<2>(o[2], vb, pa0, pa1, pa2, pa3); pv_one<3>(o[3], vb, pa0, pa1, pa2, pa3);
}
__device__ __forceinline__ void sb_scan(f32x16& p0, f32x16& p1, float& C, int hi) {
#pragma unroll
    for (int r = 0; r < 16; ++r) { p0[r] = __builtin_amdgcn_rcpf(1.0f + __builtin_amdgcn_exp2f(p0[r])); p1[r] = __builtin_amdgcn_rcpf(1.0f + __builtin_amdgcn_exp2f(p1[r])); }
    float gl[8], gh[8];
#pragma unroll
    for (int G = 0; G < 4; ++G) {
        const float g0 = (p0[4 * G] * p0[4 * G + 1]) * (p0[4 * G + 2] * p0[4 * G + 3]), g1 = (p1[4 * G] * p1[4 * G + 1]) * (p1[4 * G + 2] * p1[4 * G + 3]);
        auto r0 = __builtin_amdgcn_permlane32_swap(__float_as_uint(g0), __float_as_uint(g0), false, false);
        auto r1 = __builtin_amdgcn_permlane32_swap(__float_as_uint(g1), __float_as_uint(g1), false, false);
        gl[G] = __uint_as_float(r0[0]); gh[G] = __uint_as_float(r0[1]); gl[4 + G] = __uint_as_float(r1[0]); gh[4 + G] = __uint_as_float(r1[1]);
    }
    float E = C;
#pragma unroll
    for (int G = 3; G >= 0; --G) {
        float X = E * (hi ? 1.0f : gh[4 + G]);
#pragma unroll
        for (int i = 3; i >= 0; --i) { const float Pn = p1[4 * G + i] * X; p1[4 * G + i] = X - Pn; X = Pn; }
        E = E * (gl[4 + G] * gh[4 + G]);
    }
#pragma unroll
    for (int G = 3; G >= 0; --G) {
        float X = E * (hi ? 1.0f : gh[G]);
#pragma unroll
        for (int i = 3; i >= 0; --i) { const float Pn = p0[4 * G + i] * X; p0[4 * G + i] = X - Pn; X = Pn; }
        E = E * (gl[G] * gh[G]);
    }
    C = E;
}
__device__ __forceinline__ void attn_unit(int b, int h, int qb, const bf16_t* Q, const bf16_t* __restrict__ K, const bf16_t* __restrict__ V, bf16_t* O, char* shm) {
    int tid_ = threadIdx.x; asm volatile("" : "+v"(tid_));
    const int tid = tid_, lane = tid & 63, r32 = lane & 31, hi = lane >> 5; const int wid = __builtin_amdgcn_readfirstlane(tid >> 6);
    const long rowbase = (long)b * SEQ; const int q0w = qb * 256 + wid * 32;
    const bf16_t* Qw = Q + (rowbase + q0w + r32) * LD + h * HD + hi * 8;
    const bf16_t* Kh = K + rowbase * LD + h * HD; const bf16_t* Vh = V + rowbase * LD + h * HD;
    char* V_lds = shm; char* K_lds = shm + 2 * SHM_KV;
    bf16x8 qr[8];
#pragma unroll
    for (int d0 = 0; d0 < 8; ++d0) qr[d0] = *reinterpret_cast<const bf16x8*>(Qw + d0 * 16);
    f32x16 o[4]; o[0] = f32x16{}; o[1] = f32x16{}; o[2] = f32x16{}; o[3] = f32x16{};
    float C = 1.0f;
    const int sr = tid >> 4, sc = (tid & 15) * 8;
    const int vst0 = v_st(sr, sc), vst1 = v_st(32 + sr, sc), kst0 = KSWZ(sr, sc * 2), kst1 = KSWZ(32 + sr, sc * 2);
    const int vb0 = (int)(unsigned)(uintptr_t)V_lds + v_rd_base(lane);
    bf16x8 vs0, vs1, ks0, ks1;
#define SLOAD(k0) do { vs0 = *reinterpret_cast<const bf16x8*>(Vh + (long)((k0) + sr) * LD + sc); vs1 = *reinterpret_cast<const bf16x8*>(Vh + (long)((k0) + 32 + sr) * LD + sc); \
        ks0 = *reinterpret_cast<const bf16x8*>(Kh + (long)((k0) + sr) * LD + sc); ks1 = *reinterpret_cast<const bf16x8*>(Kh + (long)((k0) + 32 + sr) * LD + sc); } while (0)
#define SWRITE(bs) do { *reinterpret_cast<bf16x8*>(V_lds + (bs) * SHM_KV + vst0) = vs0; *reinterpret_cast<bf16x8*>(V_lds + (bs) * SHM_KV + vst1) = vs1; \
        *reinterpret_cast<bf16x8*>(K_lds + (bs) * SHM_KV + kst0) = ks0; *reinterpret_cast<bf16x8*>(K_lds + (bs) * SHM_KV + kst1) = ks1; } while (0)
    const int NT = 4 * qb + 4;
    unsigned* flags = reinterpret_cast<unsigned*>(shm + 4 * SHM_KV);
    bool wdone = false;
    SLOAD((NT - 1) * 64); SWRITE(0); __syncthreads();
    int cur = 0;
    for (int jt = NT - 1; jt >= 0; --jt) {
        if (jt > 0) SLOAD((jt - 1) * 64);
        const int k0 = jt * 64;
        if (k0 < q0w + 32 && !wdone) {
            f32x16 p0, p1;
            qkt(p0, p1, K_lds + cur * SHM_KV, qr, r32, hi);
            if (k0 + 64 > q0w) {
                const int trel = q0w + r32 - k0;
#pragma unroll
                for (int r = 0; r < 16; ++r) { const int kv = (r & 3) + 8 * (r >> 2) + 4 * hi; if (kv >= trel) p0[r] = -1e30f; if (kv + 32 >= trel) p1[r] = -1e30f; }
            }
            sb_scan(p0, p1, C, hi);
            bf16x8 pa0, pa1, pa2, pa3;
#define PK4(P, BASE, OUT) do { unsigned a0 = cvt_pk_bf16(P[BASE + 0], P[BASE + 1]), a1 = cvt_pk_bf16(P[BASE + 2], P[BASE + 3]);   \
    unsigned b0 = cvt_pk_bf16(P[BASE + 4], P[BASE + 5]), b1 = cvt_pk_bf16(P[BASE + 6], P[BASE + 7]);                              \
    auto r0 = __builtin_amdgcn_permlane32_swap(a0, b0, false, false); auto r1 = __builtin_amdgcn_permlane32_swap(a1, b1, false, false); \
    u32x4 w = {r0[0], r1[0], r0[1], r1[1]}; OUT = *reinterpret_cast<bf16x8*>(&w); } while (0)
            PK4(p0, 0, pa0); PK4(p0, 8, pa1); PK4(p1, 0, pa2); PK4(p1, 8, pa3);
#undef PK4
            pv_d0(o, vb0 + cur * SHM_KV, pa0, pa1, pa2, pa3);
            wdone = __all(C == 0.0f) != 0;
        }
        if (lane == 0) flags[(jt & 1) * 8 + wid] = wdone ? 1u : 0u;
        if (jt > 0) SWRITE(cur ^ 1);
        __syncthreads();
        cur ^= 1;
        const u32x4 f0 = *reinterpret_cast<const u32x4*>(flags + (jt & 1) * 8), f1 = *reinterpret_cast<const u32x4*>(flags + (jt & 1) * 8 + 4);
        if (__builtin_amdgcn_readfirstlane((int)(f0.x & f0.y & f0.z & f0.w & f1.x & f1.y & f1.z & f1.w)) != 0) break;
    }
    bf16_t* Ow = O + (rowbase + q0w + r32) * LD + h * HD + 4 * hi;
#pragma unroll
    for (int d0 = 0; d0 < 4; ++d0)
#pragma unroll
        for (int g = 0; g < 4; ++g) { u32x2 w; w.x = cvt_pk_bf16(o[d0][4 * g], o[d0][4 * g + 1]); w.y = cvt_pk_bf16(o[d0][4 * g + 2], o[d0][4 * g + 3]); *reinterpret_cast<u32x2*>(Ow + 32 * d0 + 8 * g) = w; }
#undef SLOAD
#undef SWRITE
}
}


__device__ __forceinline__ void p0_transpose_item(const float* __restrict__ W, int K, int N, bf16_t* __restrict__ WT, int row_off, const float* __restrict__ gain, LAS float* scr, int item, int lane) {
    const int nblk = N / 64, kb = item / nblk, nb = item % nblk, k0 = 64 * kb, n0 = 64 * nb;
    const int q = lane >> 4, m4 = (lane & 15) * 4;
    const float* src = W + (size_t)(k0 + q) * N + n0 + m4;
    f32x4 v[16];
#pragma unroll
    for (int i = 0; i < 16; ++i) v[i] = *(const f32x4*)(src + (size_t)(4 * i) * N);
    if (gain) {
#pragma unroll
        for (int i = 0; i < 16; ++i) v[i] = v[i] * gain[k0 + 4 * i + q];
    }
#pragma unroll
    for (int i = 0; i < 16; ++i)
#pragma unroll
        for (int j = 0; j < 4; ++j) scr[(m4 + j) * 65 + 4 * i + q] = v[i][j];
    LDS_WAIT(); asm volatile("" ::: "memory");
    const int c = lane & 7, nr = lane >> 3;
#pragma unroll
    for (int j = 0; j < 8; ++j) { const int n = nr + 8 * j; const LAS float* s = scr + n * 65 + 8 * c;
        u32x4 o; o.x = cvt_pk_bf16(s[0], s[1]); o.y = cvt_pk_bf16(s[2], s[3]); o.z = cvt_pk_bf16(s[4], s[5]); o.w = cvt_pk_bf16(s[6], s[7]);
        *(u32x4*)(WT + (size_t)(row_off + n0 + n) * K + k0 + 8 * c) = o; }
    LDS_WAIT(); asm volatile("" ::: "memory");
}
__device__ __forceinline__ void p0_diff_item(const float* __restrict__ x, bf16_t* __restrict__ diff, LAS float* rs, int T, int tid, int lane, int wave) {
    const int b = T >> 6, t0 = (T & 63) << 6; const long rb = (long)b * SEQ;
    for (int jj = 0; jj < 10; jj += 2) {
        const int i0 = wave + 8 * jj, i1 = i0 + 8, ta = t0 - 16 + i0, tb = t0 - 16 + i1;
        const f32x4* xa = (const f32x4*)(x + (rb + (ta > 0 ? ta : 0)) * DM) + lane; const f32x4* xb = (const f32x4*)(x + (rb + (tb > 0 ? tb : 0)) * DM) + lane;
        f32x4 va[8], vb[8];
#pragma unroll
        for (int j = 0; j < 8; ++j) { va[j] = xa[64 * j]; vb[j] = xb[64 * j]; }
        float sa = 0.f, sb = 0.f;
#pragma unroll
        for (int j = 0; j < 8; ++j) { sa += (va[j][0] * va[j][0] + va[j][1] * va[j][1]) + (va[j][2] * va[j][2] + va[j][3] * va[j][3]); sb += (vb[j][0] * vb[j][0] + vb[j][1] * vb[j][1]) + (vb[j][2] * vb[j][2] + vb[j][3] * vb[j][3]); }
        sa = wave_sum(sa); sb = wave_sum(sb);
        const float ra = ta >= 0 ? __builtin_amdgcn_rsqf(sa * (1.0f / DM) + EPS) : 0.f, rbv = tb >= 0 ? __builtin_amdgcn_rsqf(sb * (1.0f / DM) + EPS) : 0.f;
        if (lane == 0) { rs[i0] = ra; rs[i1] = rbv; }
    }
    __syncthreads();
    const int w = 2 << (wave >> 1);
    f32x4 h[16];
#pragma unroll
    for (int k = 0; k < 16; ++k) h[k] = (f32x4){0.f, 0.f, 0.f, 0.f};
    const float* xc = x + rb * DM + 4 * tid;
    for (int i8 = 0; i8 < 80; i8 += 8) {
        f32x4 v[8];
#pragma unroll
        for (int u = 0; u < 8; ++u) { const int t = t0 - 16 + i8 + u; v[u] = *(const f32x4*)(xc + (long)(t > 0 ? t : 0) * DM); }
#pragma unroll
        for (int u = 0; u < 8; ++u) {
            const int i = i8 + u, t = t0 - 16 + i;
#pragma unroll
            for (int k = 15; k >= 1; --k) h[k] = h[k - 1];
            h[0] = v[u] * rs[i];
            if (i8 >= 16) {
                f32x4 S = h[0] + h[1];
                if (w >= 4) S += h[2] + h[3];
                if (w >= 8) S += (h[4] + h[5]) + (h[6] + h[7]);
                if (w >= 16) S += ((h[8] + h[9]) + (h[10] + h[11])) + ((h[12] + h[13]) + (h[14] + h[15]));
                const int cnt = (t + 1 < w) ? (t + 1) : w; const float inv = 1.0f / (float)cnt;
                const f32x4 d = S * inv - h[0];
                u32x2 o; o.x = cvt_pk_bf16(d[0], d[1]); o.y = cvt_pk_bf16(d[2], d[3]);
                *(u32x2*)(diff + (rb + t) * DM + 4 * tid) = o;
            }
        }
    }
    __syncthreads();
}


#define XB_TMO      128
#define XB_XCNT(j)  (256  + 64 * (j))
#define XB_XSUB(j)  (1280 + 64 * (j))
#define XB_XGEN(j)  (2304 + 64 * (j))
#define XB_TOP      3328
#define XB_TOPGEN   3392
#define XCD_BAR_WORDS 3456
#define XB_SPIN_CAP (1u << 18)
__device__ __forceinline__ unsigned xb_ld(unsigned* p)              { return __hip_atomic_load(p, __ATOMIC_RELAXED, __HIP_MEMORY_SCOPE_AGENT); }
__device__ __forceinline__ unsigned xb_add(unsigned* p, unsigned v) { return __hip_atomic_fetch_add(p, v, __ATOMIC_RELAXED, __HIP_MEMORY_SCOPE_AGENT); }
__device__ __forceinline__ unsigned xb_xcc_id() { return (unsigned)__builtin_amdgcn_s_getreg((3 << 11) | 20) & 0xFu; }
#define XB_SPIN(cond, bar) do { unsigned _sp = 0; while (cond) { __builtin_amdgcn_s_sleep(1); \
    if ((++_sp & 255u) == 0u) { if (xb_ld(&(bar)[XB_TMO])) break; if (_sp > XB_SPIN_CAP) { atomicAdd(&(bar)[XB_TMO], 1u); break; } } } } while (0)
struct XcdBarrier { unsigned* bar; unsigned x; volatile LAS unsigned* st; };
__device__ __forceinline__ XcdBarrier xcd_barrier_post(unsigned* bar, volatile LAS unsigned* st) {
    XcdBarrier b; b.bar = bar; b.x = xb_xcc_id(); b.st = st;
    if (threadIdx.x == 0) (void)xb_add(&bar[XB_XCNT(b.x)], 1u);
    return b;
}
__device__ __forceinline__ void xcd_barrier_complete(unsigned* bar, unsigned x, unsigned& nloc, unsigned& nx) {
    const unsigned G = gridDim.x * gridDim.y * gridDim.z;
    unsigned sum, cnt, mine, sp = 0u;
    for (;;) {
        sum = 0u; cnt = 0u; mine = 0u;
#pragma unroll
        for (unsigned j = 0; j < 16; ++j) { const unsigned c = xb_ld(&bar[XB_XCNT(j)]); sum += c; cnt += (c > 0u) ? 1u : 0u; mine = (j == x) ? c : mine; }
        if (sum == G) break;
        __builtin_amdgcn_s_sleep(1);
        if ((++sp & 255u) == 0u) { if (xb_ld(&bar[XB_TMO])) break; if (sp > XB_SPIN_CAP) { atomicAdd(&bar[XB_TMO], 1u); break; } }
    }
    nloc = mine > 0u ? mine : 1u; nx = cnt > 0u ? cnt : 1u;
}
__device__ __forceinline__ void xcd_barrier(const XcdBarrier& b) {
    asm volatile("s_waitcnt vmcnt(0)" ::: "memory");
    __syncthreads();
    if (threadIdx.x == 0) {
        unsigned* bar = b.bar;
        __builtin_amdgcn_s_waitcnt(0);
        unsigned nloc = b.st[0], nx = b.st[1];
        if (nloc == 0u) { xcd_barrier_complete(bar, b.x, nloc, nx); b.st[0] = nloc; b.st[1] = nx; }
        const unsigned old = xb_add(&bar[XB_XSUB(b.x)], 1u);
        const unsigned gen = old / nloc;
        if (old + 1u == (gen + 1u) * nloc) {
            __builtin_amdgcn_fence(__ATOMIC_RELEASE, "agent");
            asm volatile("s_waitcnt vmcnt(0)" ::: "memory");
            const unsigned og = xb_add(&bar[XB_TOP], 1u);
            const unsigned tg = og / nx;
            if (og + 1u == (tg + 1u) * nx) xb_add(&bar[XB_TOPGEN], 1u);
            else XB_SPIN(xb_ld(&bar[XB_TOPGEN]) == tg, bar);
            __builtin_amdgcn_fence(__ATOMIC_ACQUIRE, "agent");
            xb_add(&bar[XB_XGEN(b.x)], 1u);
            asm volatile("s_waitcnt vmcnt(0)" ::: "memory");
        } else {
            XB_SPIN(xb_ld(&bar[XB_XGEN(b.x)]) == gen, bar);
            __builtin_amdgcn_fence(__ATOMIC_ACQUIRE, "agent");
            asm volatile("s_waitcnt vmcnt(0)" ::: "memory");
        }
    }
    __syncthreads();
}

struct Args { const float* in[13]; float* out; unsigned char* ws; };
__global__ void __launch_bounds__(512, 2) fwd_megakernel(Args args) {
    extern __shared__ __attribute__((aligned(16))) unsigned char lds_raw[];
    cg::grid_group grid = cg::this_grid();
    LAS unsigned char* lds = (LAS unsigned char*)lds_raw;
    const int tid = threadIdx.x, lane = tid & 63, wave = __builtin_amdgcn_readfirstlane(tid >> 6), G = gridDim.x, bid = blockIdx.x;
    const float* x = args.in[0]; const float* pool_norm = args.in[1]; const float* pool_w = args.in[2]; const float* pool_scale = args.in[3];
    const float* kv_norm = args.in[4]; const float* w_kv = args.in[5]; const float* attn_norm = args.in[6]; const float* w_q = args.in[7]; const float* w_o = args.in[8];
    const float* mlp_norm = args.in[9]; const float* w_up = args.in[10]; const float* w_down = args.in[11]; const float* final_norm = args.in[12];
    float* out = args.out; unsigned char* ws = args.ws;
    bf16_t* PWT = (bf16_t*)(ws + WS_PWT); bf16_t* WUPT = (bf16_t*)(ws + WS_WUPT); bf16_t* WDT = (bf16_t*)(ws + WS_WDT); bf16_t* WKVQT = (bf16_t*)(ws + WS_WKVQT); bf16_t* WOT = (bf16_t*)(ws + WS_WOT);
    float* SSQ = (float*)(ws + WS_SSQ); bf16_t* XB = (bf16_t*)(ws + WS_XB); bf16_t* HB = (bf16_t*)(ws + WS_H); bf16_t* DIFF = (bf16_t*)(ws + WS_DIFF);
    bf16_t* KB = (bf16_t*)(ws + WS_K); bf16_t* VB = (bf16_t*)(ws + WS_V); bf16_t* QB = (bf16_t*)(ws + WS_Q); bf16_t* OB = (bf16_t*)(ws + WS_O);

    unsigned* barw = (unsigned*)(ws + WS_BAR);
    volatile LAS unsigned* bst = (volatile LAS unsigned*)(lds + LDS_BYTES - 64);
    if (tid < 2) bst[tid] = 0u;
    __syncthreads();
    if (args.ws == nullptr) grid.sync();
    const XcdBarrier xbar = xcd_barrier_post(barw, bst);
#ifndef PROBE
#define PROBE 0
#endif
    for (int rep = 0; rep < (PROBE == 1 ? 2 : 1); ++rep) {
    for (int i = bid * 512 + tid; i < 4 * M; i += G * 512) SSQ[i] = 0.f;
    {
        LAS float* scr = (LAS float*)(lds + wave * 16896);
        const int gw = bid * 8 + wave, NGW = G * 8;
        constexpr int I_P = (512 / 64) * (512 / 64), I_UP = (DM / 64) * (FF / 64), I_DN = (FF / 64) * (DM / 64), I_KV = (DM / 64) * (2 * DM / 64), I_Q = (DM / 64) * (DM / 64);
        constexpr int NITEMS = 4 * I_P + 2 * I_UP + 2 * I_DN + I_KV + 2 * I_Q;
        for (int rep3 = 0; rep3 < (PROBE == 5 ? 2 : 1); ++rep3)
        for (int it = gw; it < NITEMS; it += NGW) {
            int r = it;
            if (r < 2 * I_UP) { const int l = r / I_UP; p0_transpose_item(w_up + (size_t)l * DM * FF, DM, FF, WUPT + (size_t)l * DM * FF, 0, mlp_norm + l * DM, scr, r % I_UP, lane); continue; } r -= 2 * I_UP;
            if (r < 2 * I_DN) { const int l = r / I_DN; p0_transpose_item(w_down + (size_t)l * DM * FF, FF, DM, WDT + (size_t)l * DM * FF, 0, nullptr, scr, r % I_DN, lane); continue; } r -= 2 * I_DN;
            if (r < I_KV) { p0_transpose_item(w_kv, DM, 2 * DM, WKVQT, 0, kv_norm, scr, r, lane); continue; } r -= I_KV;
            if (r < I_Q) { p0_transpose_item(w_q, DM, DM, WKVQT, 2 * DM, attn_norm, scr, r, lane); continue; } r -= I_Q;
            if (r < I_Q) { p0_transpose_item(w_o, DM, DM, WOT, 0, nullptr, scr, r, lane); continue; } r -= I_Q;
            { const int g = r / I_P; p0_transpose_item(pool_w + (size_t)g * 512 * 512, 512, 512, PWT, g * 512, pool_norm + g * 512, scr, r % I_P, lane); }
        }
    }
    __syncthreads();
    for (int rep2 = 0; rep2 < (PROBE == 4 ? 2 : 1); ++rep2)
    for (int T = bid; T < M / 64; T += G) p0_diff_item(x, DIFF, (LAS float*)(lds + 140000), T, tid, lane, wave);
    }
    xcd_barrier(xbar);

    {
        pg8::Gemm g{DIFF, PWT, M, DM, 512, DM, 1, 512}; pg8::StaticOrder S; S.init(M, DM, G, bid, 4);
        pg8::EpiRes<true> E{x, XB, pool_scale, SSQ, nullptr};
        pg8::gemm_phase<pg8::EpiRes<true>, pg8::StaticOrder, true, true>(lds, g, S, E);
    }
    xcd_barrier(xbar);
    for (int rep = 0; rep < (PROBE == 2 ? 2 : 1); ++rep) {
        pg8::Gemm g{XB, WUPT, M, FF, DM, DM, 0, 0}; pg8::StaticOrder S; S.init(M, FF, G, bid, 2);
        pg8::EpiUp E{HB};
        pg8::gemm_phase<pg8::EpiUp, pg8::StaticOrder, true, true>(lds, g, S, E);
    }
    xcd_barrier(xbar);
    {
        pg8::Gemm g{HB, WDT, M, DM, FF, FF, 0, 0}; pg8::StaticOrder S; S.init(M, DM, G, bid, 4, 1);
        pg8::EpiRes<false> E{nullptr, XB, nullptr, SSQ + M, SSQ};
        pg8::gemm_phase<pg8::EpiRes<false>, pg8::StaticOrder, true, true>(lds, g, S, E);
    }
    xcd_barrier(xbar);
    {
        pg8::Gemm g{XB, WKVQT, M, 3 * DM, DM, DM, 0, 0}; pg8::StaticOrder S; S.init(M, 3 * DM, G, bid, 2);
        pg8::EpiKVQ E{SSQ + M, KB};
        pg8::gemm_phase<pg8::EpiKVQ, pg8::StaticOrder, true, true>(lds, g, S, E);
    }
    xcd_barrier(xbar);
    {
        for (int rep = 0; rep < (PROBE == 3 ? 2 : 1); ++rep)
        for (int L = bid; L < NBATCH * NH * 16; L += G) {
            const int c = L & 255, i = L >> 8, bh = c >> 2, j = c & 3;
            const int qb = (i == 0) ? 15 - j : (i == 1) ? 8 + j : (i == 2) ? 7 - j : j;
            att::attn_unit(bh >> 4, bh & 15, qb, QB, KB, VB, OB, (char*)lds_raw);
        }
    }
    xcd_barrier(xbar);
    {
        pg8::Gemm g{OB, WOT, M, DM, DM, DM, 0, 0}; pg8::StaticOrder S; S.init(M, DM, G, bid, 4);
        pg8::EpiRes<false> E{nullptr, XB, nullptr, SSQ + 2 * M, nullptr};
        pg8::gemm_phase<pg8::EpiRes<false>, pg8::StaticOrder, true, true>(lds, g, S, E);
    }
    xcd_barrier(xbar);
    {
        pg8::Gemm g{XB, WUPT + (size_t)DM * FF, M, FF, DM, DM, 0, 0}; pg8::StaticOrder S; S.init(M, FF, G, bid, 2);
        pg8::EpiUp E{HB};
        pg8::gemm_phase<pg8::EpiUp, pg8::StaticOrder, true, true>(lds, g, S, E);
    }
    xcd_barrier(xbar);
    if (G == 256) {
        pg8::Gemm g{HB, WDT + (size_t)DM * FF, M, DM, FF, FF, 0, 0}; pg8::StaticOrder S; S.init(M, DM, G, bid, 4, 1);
        pg8::EpiFinal E{XB, SSQ + 2 * M, SSQ + 3 * M, barw + XCD_BAR_WORDS, final_norm, out};
        pg8::gemm_phase<pg8::EpiFinal, pg8::StaticOrder, true, true>(lds, g, S, E);
    } else {
        {
            pg8::Gemm g{HB, WDT + (size_t)DM * FF, M, DM, FF, FF, 0, 0}; pg8::StaticOrder S; S.init(M, DM, G, bid, 4, 1);
            pg8::EpiRes<false> E{nullptr, XB, nullptr, SSQ + 3 * M, SSQ + 2 * M};
            pg8::gemm_phase<pg8::EpiRes<false>, pg8::StaticOrder, true, true>(lds, g, S, E);
        }
        xcd_barrier(xbar);
        const float* ssq = SSQ + 3 * M;
        for (int m = bid * 8 + wave; m < M; m += G * 8) {
            const float rstd = __builtin_amdgcn_rsqf(ssq[m] * (1.0f / DM) + EPS);
            const u32x4* xr = (const u32x4*)(XB + (size_t)m * DM) + lane; f32x4* orow = (f32x4*)(out + (size_t)m * DM) + 2 * lane; const f32x4* gr = (const f32x4*)final_norm + 2 * lane;
#pragma unroll
            for (int j = 0; j < 4; ++j) {
                const u32x4 q = xr[64 * j];
                const f32x4 a = (f32x4){__uint_as_float(q.x << 16), __uint_as_float(q.x & 0xffff0000u), __uint_as_float(q.y << 16), __uint_as_float(q.y & 0xffff0000u)};
                const f32x4 b = (f32x4){__uint_as_float(q.z << 16), __uint_as_float(q.z & 0xffff0000u), __uint_as_float(q.w << 16), __uint_as_float(q.w & 0xffff0000u)};
                orow[128 * j] = a * rstd * gr[128 * j]; orow[128 * j + 1] = b * rstd * gr[128 * j + 1];
            }
        }
    }
}

extern "C" void kernel_launch(void* const* d_in, const int* in_sizes, int n_in, void* d_out, int out_size, void* d_ws, size_t ws_size, hipStream_t stream) {
    static int grid = 0;
    if (grid == 0) {
        if (n_in != 13 || in_sizes[0] != M * DM || out_size != M * DM || ws_size < WS_END) { fprintf(stderr, "kernel_launch: unexpected shapes: n_in %d in0 %d out %d ws %zu (need %zu)\n", n_in, n_in > 0 ? in_sizes[0] : -1, out_size, ws_size, (size_t)WS_END); grid = -1; return; }
        int dev = 0, cus = 0, per_cu = 0;
        if (hipGetDevice(&dev) != hipSuccess || hipDeviceGetAttribute(&cus, hipDeviceAttributeMultiprocessorCount, dev) != hipSuccess) { fprintf(stderr, "kernel_launch: device query failed\n"); grid = -1; return; }
        if (hipFuncSetAttribute((const void*)fwd_megakernel, hipFuncAttributeMaxDynamicSharedMemorySize, LDS_BYTES) != hipSuccess) { fprintf(stderr, "kernel_launch: hipFuncSetAttribute failed\n"); grid = -1; return; }
        if (hipOccupancyMaxActiveBlocksPerMultiprocessor(&per_cu, (const void*)fwd_megakernel, 512, LDS_BYTES) != hipSuccess || per_cu < 1) { fprintf(stderr, "kernel_launch: occupancy query gave %d\n", per_cu); per_cu = 1; }
        (void)hipGetLastError();
        grid = cus * per_cu;
    }
    if (grid < 0) return;
    if (hipMemsetAsync((char*)d_ws + WS_BAR, 0, (XCD_BAR_WORDS + 64 * 64) * sizeof(unsigned), stream) != hipSuccess) { fprintf(stderr, "kernel_launch: hipMemsetAsync of the barrier words failed; nothing launched\n"); return; }
    Args a{};
    for (int i = 0; i < 13; ++i) a.in[i] = (const float*)d_in[i];
    a.out = (float*)d_out; a.ws = (unsigned char*)d_ws;
    void* kargs[] = {&a};
    hipError_t e = hipLaunchCooperativeKernel((const void*)fwd_megakernel, dim3(grid), dim3(512), kargs, LDS_BYTES, stream);
    if (e != hipSuccess) fprintf(stderr, "kernel_launch: cooperative launch failed: %s (grid %d)\n", hipGetErrorString(e), grid);
}
```

```cpp
#define PROBE 0
#include <hip/hip_runtime.h>
#include <hip/hip_cooperative_groups.h>
#include <cstdio>
#include <cstdint>
namespace cg = cooperative_groups;

#define LAS __attribute__((address_space(3)))
typedef unsigned short bf16_t;
typedef short bf16x8 __attribute__((ext_vector_type(8)));
typedef short s16x4 __attribute__((ext_vector_type(4)));
typedef float f32x4 __attribute__((ext_vector_type(4)));
typedef float f32x16 __attribute__((ext_vector_type(16)));
typedef unsigned u32x4 __attribute__((ext_vector_type(4)));
typedef unsigned u32x2 __attribute__((ext_vector_type(2)));

constexpr int DM = 2048, NBATCH = 4, SEQ = 4096, M = NBATCH * SEQ, FF = 8192, NH = 16, HD = 128;
constexpr float EPS = 1e-6f;
constexpr float C2 = 0.08838834764831845f * 1.4426950408889634f;

constexpr size_t MiB = 1u << 20;
constexpr size_t WS_PWT = 0;
constexpr size_t WS_WUPT = 2 * MiB;
constexpr size_t WS_WDT = 66 * MiB;
constexpr size_t WS_WKVQT = 130 * MiB;
constexpr size_t WS_WOT = 154 * MiB;
constexpr size_t WS_SSQ = 162 * MiB;
constexpr size_t WS_BAR = 162 * MiB + 512 * 1024;
constexpr size_t WS_XB = 163 * MiB;
constexpr size_t WS_H = 227 * MiB;
constexpr size_t WS_DIFF = WS_H, WS_K = WS_H, WS_V = WS_H + 64 * MiB, WS_Q = WS_H + 128 * MiB, WS_O = WS_H + 192 * MiB;
constexpr size_t WS_END = 483 * MiB;
constexpr int LDS_BYTES = 147456;

#define LDS_WAIT() asm volatile("s_waitcnt lgkmcnt(0)" ::: "memory")
__device__ __forceinline__ unsigned f2bf(float f) { unsigned u = __builtin_bit_cast(unsigned, f); return (u + 0x7fffu + ((u >> 16) & 1u)) >> 16; }
__device__ __forceinline__ unsigned pk2(float lo, float hi) { return f2bf(lo) | (f2bf(hi) << 16); }
typedef float f32x2_t __attribute__((ext_vector_type(2))); typedef __bf16 bf16x2_t __attribute__((ext_vector_type(2)));
__device__ __forceinline__ unsigned cvt_pk_bf16(float lo, float hi) { const f32x2_t v = {lo, hi}; const bf16x2_t b = __builtin_convertvector(v, bf16x2_t); return __builtin_bit_cast(unsigned, b); }
__device__ __forceinline__ float wave_sum(float v) {
#pragma unroll
    for (int o = 1; o < 64; o <<= 1) v += __shfl_xor(v, o);
    return v;
}

namespace pg8 {
constexpr int BM = 256, BK = 64, HALF = 128, HTB = HALF * BK * 2, STAGE_BYTES = 8 * HTB, NXCD = 8, WGM = 8;
__host__ __device__ __forceinline__ int lds_byte(int r, int c) { const int st = (r >> 4) * 2 + (c >> 5), rr = r & 15, cc = c & 31, ob = rr * 64 + cc * 2; return st * 1024 + (ob ^ (((ob >> 9) & 1) << 5)); }
__host__ __device__ __forceinline__ void stage_rc(int b, int& R, int& C) { const int st = b / 1024, sb = b % 1024, swz = sb ^ (((sb >> 9) & 1) << 5); R = (st >> 1) * 16 + swz / 64; C = (st & 1) * 32 + (swz % 64) / 2; }
__host__ __device__ __forceinline__ int perm32(int rho) { const int n = rho >> 4, i = rho & 15; return 8 * (i >> 2) + 4 * n + (i & 3); }

struct Unit { int pm, pn; };
struct Gemm { const bf16_t* A; const bf16_t* Bt; int M, N, K, lda, a_shift, a_cols; };

struct StaticOrder {
    int nM, nN, nwg, G, c, wgm;
    __host__ __device__ void init(int M_, int N_, int G_, int c_, int wgm_ = WGM) { nM = M_ / BM; nN = N_ / BM; nwg = nM * nN; G = G_; c = c_; wgm = wgm_; }
    __host__ __device__ bool next(int i, Unit& u) const {
        const long L = (long)i * G + c; if (L >= nwg) return false;
        int wgid = (int)L; { const int q = nwg / NXCD, r = nwg % NXCD, xcd = wgid % NXCD, off = wgid / NXCD; wgid = (xcd < r ? xcd * (q + 1) : r * (q + 1) + (xcd - r) * q) + off; }
        const int nig = wgm * nN, gid = wgid / nig, fm = gid * wgm, gsz = (nM - fm) < wgm ? (nM - fm) : wgm;
        u.pm = fm + ((wgid % nig) % gsz); u.pn = (wgid % nig) / gsz; return true;
    }
};


template <bool IN32> struct EpiRes {
    static constexpr bool PERM = true;
    const float* Xin32; bf16_t* XB; const float* scale; float* ssq; const float* rs_ssq;
    __device__ __forceinline__ void operator()(const f32x4 (&acc)[2][2][4][2], const Unit& u, int wr, int wc, int fr, int fq) const {
        const int row0 = u.pm * BM + wr * 64 + fr, col0 = u.pn * BM + wc * 32 + 8 * fq;
        f32x4 sv[2][2];
#pragma unroll
        for (int bj = 0; bj < 2; ++bj)
#pragma unroll
            for (int n = 0; n < 2; ++n) sv[bj][n] = scale ? *(const f32x4*)(scale + col0 + bj * HALF + 4 * n) : (f32x4){1.f, 1.f, 1.f, 1.f};
#pragma unroll
        for (int ai = 0; ai < 2; ++ai)
#pragma unroll
            for (int m = 0; m < 4; ++m) {
                const int row = row0 + ai * HALF + m * 16; const size_t ro = (size_t)row * DM + col0; float s = 0.f;
                const float rsc = rs_ssq ? __builtin_amdgcn_rcpf(rs_ssq[row] * (1.0f / DM) + EPS) : 1.0f;
#pragma unroll
                for (int bj = 0; bj < 2; ++bj) {
                    f32x4 r0, r1;
                    if constexpr (IN32) { r0 = *(const f32x4*)(Xin32 + ro + bj * HALF); r1 = *(const f32x4*)(Xin32 + ro + bj * HALF + 4); }
                    else { const u32x4 q = *(const u32x4*)(XB + ro + bj * HALF);
                        r0 = (f32x4){__uint_as_float(q.x << 16), __uint_as_float(q.x & 0xffff0000u), __uint_as_float(q.y << 16), __uint_as_float(q.y & 0xffff0000u)};
                        r1 = (f32x4){__uint_as_float(q.z << 16), __uint_as_float(q.z & 0xffff0000u), __uint_as_float(q.w << 16), __uint_as_float(q.w & 0xffff0000u)}; }
                    const f32x4 v0 = acc[ai][bj][m][0] * (sv[bj][0] * rsc) + r0, v1 = acc[ai][bj][m][1] * (sv[bj][1] * rsc) + r1;
                    u32x4 w; w.x = cvt_pk_bf16(v0[0], v0[1]); w.y = cvt_pk_bf16(v0[2], v0[3]); w.z = cvt_pk_bf16(v1[0], v1[1]); w.w = cvt_pk_bf16(v1[2], v1[3]); *(u32x4*)(XB + ro + bj * HALF) = w;
                    s += (v0[0] * v0[0] + v0[1] * v0[1]) + (v0[2] * v0[2] + v0[3] * v0[3]) + (v1[0] * v1[0] + v1[1] * v1[1]) + (v1[2] * v1[2] + v1[3] * v1[3]);
                }
                s += __shfl_xor(s, 16); s += __shfl_xor(s, 32);
                if (fq == 0) unsafeAtomicAdd(ssq + row, s);
            }
    }
};
struct EpiFinal {
    static constexpr bool PERM = true;
    const bf16_t* XB; const float* rs_ssq; float* ssq; unsigned* cnt; const float* gain; float* out;
    __device__ __forceinline__ void operator()(f32x4 (&acc)[2][2][4][2], const Unit& u, int wr, int wc, int fr, int fq) const {
        const int row0 = u.pm * BM + wr * 64 + fr, col0 = u.pn * BM + wc * 32 + 8 * fq;
#pragma unroll
        for (int ai = 0; ai < 2; ++ai)
#pragma unroll
            for (int m = 0; m < 4; ++m) {
                const int row = row0 + ai * HALF + m * 16; const size_t ro = (size_t)row * DM + col0; float s = 0.f;
                const float rsc = __builtin_amdgcn_rcpf(rs_ssq[row] * (1.0f / DM) + EPS);
#pragma unroll
                for (int bj = 0; bj < 2; ++bj) {
                    const u32x4 q = *(const u32x4*)(XB + ro + bj * HALF);
                    const f32x4 r0 = (f32x4){__uint_as_float(q.x << 16), __uint_as_float(q.x & 0xffff0000u), __uint_as_float(q.y << 16), __uint_as_float(q.y & 0xffff0000u)};
                    const f32x4 r1 = (f32x4){__uint_as_float(q.z << 16), __uint_as_float(q.z & 0xffff0000u), __uint_as_float(q.w << 16), __uint_as_float(q.w & 0xffff0000u)};
                    const f32x4 v0 = acc[ai][bj][m][0] * rsc + r0, v1 = acc[ai][bj][m][1] * rsc + r1;
                    acc[ai][bj][m][0] = v0; acc[ai][bj][m][1] = v1;
                    s += (v0[0] * v0[0] + v0[1] * v0[1]) + (v0[2] * v0[2] + v0[3] * v0[3]) + (v1[0] * v1[0] + v1[1] * v1[1]) + (v1[2] * v1[2] + v1[3] * v1[3]);
                }
                s += __shfl_xor(s, 16); s += __shfl_xor(s, 32);
                if (fq == 0) unsafeAtomicAdd(ssq + row, s);
            }
        asm volatile("s_waitcnt vmcnt(0)" ::: "memory");
        unsigned* pc = cnt + 64 * u.pm;
        if (fr == 0 && fq == 0) (void)__hip_atomic_fetch_add(pc, 1u, __ATOMIC_RELAXED, __HIP_MEMORY_SCOPE_AGENT);
        { unsigned sp = 0;
          while ((unsigned)__builtin_amdgcn_readfirstlane((int)__hip_atomic_load(pc, __ATOMIC_RELAXED, __HIP_MEMORY_SCOPE_AGENT)) < 64u) { __builtin_amdgcn_s_sleep(2); if (++sp > (1u << 22)) break; } }
        asm volatile("" ::: "memory");
#pragma unroll
        for (int ai = 0; ai < 2; ++ai)
#pragma unroll
            for (int m = 0; m < 4; ++m) {
                const int row = row0 + ai * HALF + m * 16; const size_t ro = (size_t)row * DM + col0;
                const float tot = __hip_atomic_load(ssq + row, __ATOMIC_RELAXED, __HIP_MEMORY_SCOPE_AGENT);
                const float rstd = __builtin_amdgcn_rsqf(tot * (1.0f / DM) + EPS);
#pragma unroll
                for (int bj = 0; bj < 2; ++bj) {
                    const f32x4 g0 = *(const f32x4*)(gain + col0 + bj * HALF), g1 = *(const f32x4*)(gain + col0 + bj * HALF + 4);
                    *(f32x4*)(out + ro + bj * HALF) = acc[ai][bj][m][0] * rstd * g0; *(f32x4*)(out + ro + bj * HALF + 4) = acc[ai][bj][m][1] * rstd * g1;
                }
            }
    }
};
struct EpiUp {
    static constexpr bool PERM = true;
    bf16_t* H;
    __device__ __forceinline__ void operator()(const f32x4 (&acc)[2][2][4][2], const Unit& u, int wr, int wc, int fr, int fq) const {
        const int row0 = u.pm * BM + wr * 64 + fr, col0 = u.pn * BM + wc * 32 + 8 * fq;
#pragma unroll
        for (int ai = 0; ai < 2; ++ai)
#pragma unroll
            for (int m = 0; m < 4; ++m) {
                const int row = row0 + ai * HALF + m * 16;
                bf16_t* rowp = H + (size_t)row * FF + col0;
#pragma unroll
                for (int bj = 0; bj < 2; ++bj) {
                    f32x4 v0 = acc[ai][bj][m][0], v1 = acc[ai][bj][m][1];
#pragma unroll
                    for (int j = 0; j < 4; ++j) { v0[j] = fmaxf(v0[j], 0.f); v0[j] *= v0[j]; v1[j] = fmaxf(v1[j], 0.f); v1[j] *= v1[j]; }
                    u32x4 w; w.x = cvt_pk_bf16(v0[0], v0[1]); w.y = cvt_pk_bf16(v0[2], v0[3]); w.z = cvt_pk_bf16(v1[0], v1[1]); w.w = cvt_pk_bf16(v1[2], v1[3]);
                    *(u32x4*)(rowp + bj * HALF) = w;
                }
            }
    }
};
struct EpiKVQ {
    static constexpr bool PERM = true;
    const float* ssq; bf16_t* KVQ;
    __device__ __forceinline__ void operator()(const f32x4 (&acc)[2][2][4][2], const Unit& u, int wr, int wc, int fr, int fq) const {
        const int row0 = u.pm * BM + wr * 64 + fr; int colt = u.pn * BM; const int t = colt / DM; colt -= t * DM;
        bf16_t* base = KVQ + (size_t)t * ((size_t)M * DM); const float sc = (t == 2) ? C2 : 1.0f;
        const int col0 = colt + wc * 32 + 8 * fq;
#pragma unroll
        for (int ai = 0; ai < 2; ++ai)
#pragma unroll
            for (int m = 0; m < 4; ++m) {
                const int row = row0 + ai * HALF + m * 16; const float rstd = __builtin_amdgcn_rsqf(ssq[row] * (1.0f / DM) + EPS) * sc;
                bf16_t* rowp = base + (size_t)row * DM + col0;
#pragma unroll
                for (int bj = 0; bj < 2; ++bj) {
                    const f32x4 v0 = acc[ai][bj][m][0] * rstd, v1 = acc[ai][bj][m][1] * rstd;
                    u32x4 w; w.x = cvt_pk_bf16(v0[0], v0[1]); w.y = cvt_pk_bf16(v0[2], v0[3]); w.z = cvt_pk_bf16(v1[0], v1[1]); w.w = cvt_pk_bf16(v1[2], v1[3]);
                    *(u32x4*)(rowp + bj * HALF) = w;
                }
            }
    }
};
template <class Epi, class Sched, bool ALIGN_EPI = false, bool SP2 = false>
__device__ __forceinline__ void gemm_phase(LAS unsigned char* lds, const Gemm g, const Sched& S, const Epi& E) {
    int tid_ = threadIdx.x; asm volatile("" : "+v"(tid_));
    const int tid = tid_, wid = __builtin_amdgcn_readfirstlane(tid >> 6), lane = tid & 63, wr = wid >> 2, wc = wid & 3, fr = lane & 15, fq = lane >> 4;
    const int K = g.K, nt = K / BK, lda = g.lda;
    unsigned voffA[2], voffB[2];
#pragma unroll
    for (int i = 0; i < 2; ++i) { int R, C; stage_rc(tid * 16 + i * 8192, R, C); const int Rb = Epi::PERM ? ((R & ~31) + perm32(R & 31)) : R;
        voffA[i] = (unsigned)(R * lda + C) * 2u; voffB[i] = (unsigned)(Rb * K + C) * 2u; }
    const size_t kstep = (size_t)(BK * 2);
    const size_t hstepA = (size_t)HALF * lda * 2, hstepB = (size_t)HALF * K * 2;
    const size_t tstepA = 2 * hstepA, tstepB = 2 * hstepB;
    const unsigned ldsw = (unsigned)wid * 1024u;
    const int aoff = lds_byte(wr * 64 + fr, fq * 8), boff = lds_byte(wc * 32 + fr, fq * 8);
#define PG8_SA(b, h) (((b) * 2 + (h)) * HTB)
#define PG8_SB(b, h) ((4 + (b) * 2 + (h)) * HTB)
    const __amdgpu_buffer_rsrc_t rsA = __builtin_amdgcn_make_buffer_rsrc((void*)g.A, 0, 0x7FFFF000, 0x00020000), rsB = __builtin_amdgcn_make_buffer_rsrc((void*)g.Bt, 0, 0x7FFFF000, 0x00020000);
#define PG8_STAGE(bufoff, gptr, voff) do { const bool isA_ = ((const void*)(voff) == (const void*)voffA); \
        const unsigned so_ = (unsigned)((const char*)(gptr) - (isA_ ? (const char*)g.A : (const char*)g.Bt)); \
        _Pragma("unroll") for (int _i = 0; _i < 2; ++_i) { \
            if (isA_) __builtin_amdgcn_raw_ptr_buffer_load_lds(rsA, (LAS unsigned*)(lds + (bufoff) + ldsw + _i * 8192), 16, (voff)[_i], so_, 0, 0); \
            else      __builtin_amdgcn_raw_ptr_buffer_load_lds(rsB, (LAS unsigned*)(lds + (bufoff) + ldsw + _i * 8192), 16, (voff)[_i], so_, 0, 0); } } while (0)
#define PG8_LDA(dst, b, h) do { _Pragma("unroll") for (int m = 0; m < 4; ++m) _Pragma("unroll") for (int k = 0; k < 2; ++k) dst[m][k] = *(const LAS bf16x8*)(lds + PG8_SA(b, h) + aoff + m * 2048 + k * 1024); } while (0)
#define PG8_LDB(dst, b, h) do { _Pragma("unroll") for (int n = 0; n < 2; ++n) _Pragma("unroll") for (int k = 0; k < 2; ++k) dst[n][k] = *(const LAS bf16x8*)(lds + PG8_SB(b, h) + boff + n * 2048 + k * 1024); } while (0)
#define PG8_MMA(ai, bj, At, Bt) do { __builtin_amdgcn_s_setprio(1); _Pragma("unroll") for (int m = 0; m < 4; ++m) _Pragma("unroll") for (int n = 0; n < 2; ++n) _Pragma("unroll") for (int k = 0; k < 2; ++k) \
        acc[ai][bj][m][n] = __builtin_amdgcn_mfma_f32_16x16x32_bf16(Bt[n][k], At[m][k], acc[ai][bj][m][n], 0, 0, 0); __builtin_amdgcn_s_setprio(0); } while (0)
#define PG8_WAIT_V(n) asm volatile("s_waitcnt vmcnt(" #n ")" ::: "memory")
#define PG8_WAIT_L(n) asm volatile("s_waitcnt lgkmcnt(" #n ")" ::: "memory")
#define PG8_BAR __builtin_amdgcn_s_barrier()
#define PG8_SCHED __builtin_amdgcn_sched_barrier(0)
    Unit cur, nxt; int ui = 0;
    if (!S.next(0, cur)) return;
    f32x4 acc[2][2][4][2];
#pragma unroll
    for (int a = 0; a < 2; ++a)
#pragma unroll
        for (int b = 0; b < 2; ++b)
#pragma unroll
            for (int m = 0; m < 4; ++m)
#pragma unroll
                for (int n = 0; n < 2; ++n) acc[a][b][m][n] = (f32x4){0.f, 0.f, 0.f, 0.f};
    bf16x8 At[4][2], B0[2][2], B1[2][2];
    const char* cA = (const char*)g.A + (size_t)cur.pm * tstepA + (size_t)((cur.pn >> g.a_shift) * g.a_cols) * 2; const char* cB = (const char*)g.Bt + (size_t)cur.pn * tstepB;
    if constexpr (SP2) {
        PG8_STAGE(PG8_SB(0, 0), cB, voffB); PG8_STAGE(PG8_SB(0, 1), cB + hstepB, voffB); PG8_STAGE(PG8_SA(0, 0), cA, voffA); PG8_STAGE(PG8_SA(0, 1), cA + hstepA, voffA);
        if (wr == 1) PG8_BAR;
        PG8_WAIT_V(2); PG8_BAR;
        PG8_STAGE(PG8_SB(1, 0), cB + kstep, voffB); PG8_STAGE(PG8_SA(1, 0), cA + kstep, voffA); PG8_STAGE(PG8_SB(1, 1), cB + hstepB + kstep, voffB);
        PG8_WAIT_V(6); PG8_BAR;
    } else {
        PG8_STAGE(PG8_SB(0, 0), cB, voffB); PG8_STAGE(PG8_SA(0, 0), cA, voffA); PG8_STAGE(PG8_SB(0, 1), cB + hstepB, voffB); PG8_STAGE(PG8_SA(0, 1), cA + hstepA, voffA);
        if (wr == 1) PG8_BAR;
        PG8_WAIT_V(4); PG8_BAR;
        PG8_STAGE(PG8_SB(1, 0), cB + kstep, voffB); PG8_STAGE(PG8_SA(1, 0), cA + kstep, voffA); PG8_STAGE(PG8_SB(1, 1), cB + hstepB + kstep, voffB);
        PG8_WAIT_V(6); PG8_BAR;
    }
    for (;;) {
        const bool has_next = S.next(ui + 1, nxt);
        const char* nA = has_next ? (const char*)g.A + (size_t)nxt.pm * tstepA + (size_t)((nxt.pn >> g.a_shift) * g.a_cols) * 2 : cA; const char* nB = has_next ? (const char*)g.Bt + (size_t)nxt.pn * tstepB : cB;
        for (int t = 0; t < nt; t += 2) {
            const bool last = (t == nt - 2);
            const char* a1 = cA + (size_t)(t + 1) * kstep;
            const char* a2 = last ? nA : cA + (size_t)(t + 2) * kstep; const char* b2 = last ? nB : cB + (size_t)(t + 2) * kstep;
            const char* a3 = a2 + kstep; const char* b3 = b2 + kstep;
            if constexpr (SP2) {
            PG8_LDB(B0, 0, 0); PG8_LDB(B1, 0, 1); PG8_SCHED; PG8_LDA(At, 0, 0); PG8_STAGE(PG8_SA(1, 1), a1 + hstepA, voffA);
            PG8_WAIT_V(8); PG8_WAIT_L(0); PG8_BAR; PG8_MMA(0, 0, At, B0); PG8_MMA(0, 1, At, B1); PG8_BAR; PG8_SCHED;
            PG8_LDA(At, 0, 1); PG8_STAGE(PG8_SB(0, 0), b2, voffB); PG8_STAGE(PG8_SB(0, 1), b2 + hstepB, voffB); PG8_STAGE(PG8_SA(0, 0), a2, voffA);
            PG8_WAIT_V(8); PG8_WAIT_L(0); PG8_BAR; PG8_MMA(1, 0, At, B0); PG8_MMA(1, 1, At, B1); PG8_BAR; PG8_SCHED;
            PG8_LDB(B0, 1, 0); PG8_LDB(B1, 1, 1); PG8_SCHED; PG8_LDA(At, 1, 0); PG8_STAGE(PG8_SA(0, 1), a2 + hstepA, voffA);
            PG8_WAIT_V(8); PG8_WAIT_L(0); PG8_BAR; PG8_MMA(0, 0, At, B0); PG8_MMA(0, 1, At, B1); PG8_BAR; PG8_SCHED;
            PG8_LDA(At, 1, 1); PG8_STAGE(PG8_SB(1, 0), b3, voffB); PG8_STAGE(PG8_SB(1, 1), b3 + hstepB, voffB); PG8_STAGE(PG8_SA(1, 0), a3, voffA);
            PG8_WAIT_V(8); PG8_WAIT_L(0); PG8_BAR; PG8_MMA(1, 0, At, B0); PG8_MMA(1, 1, At, B1); PG8_BAR; PG8_SCHED;
            } else {
            PG8_LDB(B0, 0, 0); PG8_SCHED; PG8_LDA(At, 0, 0); PG8_STAGE(PG8_SA(1, 1), a1 + hstepA, voffA);
            PG8_WAIT_L(8); PG8_BAR; PG8_WAIT_L(0); PG8_MMA(0, 0, At, B0); PG8_BAR; PG8_SCHED;
            PG8_LDB(B1, 0, 1); PG8_STAGE(PG8_SB(0, 0), b2, voffB);
            PG8_BAR; PG8_WAIT_L(0); PG8_MMA(0, 1, At, B1); PG8_BAR;
            PG8_LDA(At, 0, 1); PG8_STAGE(PG8_SA(0, 0), a2, voffA);
            PG8_BAR; PG8_WAIT_L(0); PG8_MMA(1, 0, At, B0); PG8_BAR; PG8_SCHED;
            PG8_STAGE(PG8_SB(0, 1), b2 + hstepB, voffB);
            PG8_WAIT_V(6); PG8_BAR; PG8_MMA(1, 1, At, B1); PG8_BAR;
            PG8_LDB(B0, 1, 0); PG8_SCHED; PG8_LDA(At, 1, 0); PG8_STAGE(PG8_SA(0, 1), a2 + hstepA, voffA);
            PG8_WAIT_L(8); PG8_BAR; PG8_WAIT_L(0); PG8_MMA(0, 0, At, B0); PG8_BAR; PG8_SCHED;
            PG8_LDB(B1, 1, 1); PG8_STAGE(PG8_SB(1, 0), b3, voffB);
            PG8_BAR; PG8_WAIT_L(0); PG8_MMA(0, 1, At, B1); PG8_BAR;
            PG8_LDA(At, 1, 1); PG8_STAGE(PG8_SA(1, 0), a3, voffA);
            PG8_BAR; PG8_WAIT_L(0); PG8_MMA(1, 0, At, B0); PG8_BAR; PG8_SCHED;
            PG8_STAGE(PG8_SB(1, 1), b3 + hstepB, voffB);
            PG8_WAIT_V(6); PG8_BAR; PG8_MMA(1, 1, At, B1); PG8_BAR;
            }
        }
        if constexpr (ALIGN_EPI) { if (wr == 0) PG8_BAR; }
        E(acc, cur, wr, wc, fr, fq);
        if (!has_next) break;
#pragma unroll
        for (int a = 0; a < 2; ++a)
#pragma unroll
            for (int b = 0; b < 2; ++b)
#pragma unroll
                for (int m = 0; m < 4; ++m)
#pragma unroll
                    for (int n = 0; n < 2; ++n) acc[a][b][m][n] = (f32x4){0.f, 0.f, 0.f, 0.f};
        cur = nxt; cA = nA; cB = nB; ++ui;
        if constexpr (ALIGN_EPI) { if (wr == 1) PG8_BAR; }
    }
    PG8_WAIT_V(0);
    if constexpr (!ALIGN_EPI) { if (wr == 0) PG8_BAR; }
    PG8_BAR;
#undef PG8_SA
#undef PG8_SB
#undef PG8_STAGE
#undef PG8_LDA
#undef PG8_LDB
#undef PG8_MMA
#undef PG8_WAIT_V
#undef PG8_WAIT_L
#undef PG8_BAR
#undef PG8_SCHED
}

}

namespace att {
constexpr int LD = DM;
constexpr int SHM_KV = 16384;
#define KSWZ(row, colB) ((row) * 256 + ((colB) ^ (((row) & 7) << 4)))
#define SBAR() __builtin_amdgcn_sched_barrier(0)
__device__ __forceinline__ int crow(int r, int hi) { return (r & 3) + 8 * (r >> 2) + 4 * hi; }
__device__ __forceinline__ void qkt(f32x16& p0, f32x16& p1, const char* Ks, const bf16x8* qr, int r32, int hi) {
    p0 = f32x16{}; p1 = f32x16{};
#pragma unroll
    for (int d0 = 0; d0 < 8; ++d0) { const int cb = (d0 * 16 + hi * 8) * 2;
        const bf16x8 b0 = *reinterpret_cast<const bf16x8*>(Ks + KSWZ(r32, cb));
        const bf16x8 b1 = *reinterpret_cast<const bf16x8*>(Ks + KSWZ(32 + r32, cb));
        p0 = __builtin_amdgcn_mfma_f32_32x32x16_bf16(b0, qr[d0], p0, 0, 0, 0);
        p1 = __builtin_amdgcn_mfma_f32_32x32x16_bf16(b1, qr[d0], p1, 0, 0, 0); }
}
__device__ __forceinline__ int v_st(int k, int c) { const int kk = (k & ~0xC) | ((k & 4) << 1) | ((k & 8) >> 1); return ((kk >> 3) * 4 + (c >> 5)) * 512 + ((kk & 7) * 32 + (c & 31)) * 2; }
__device__ __forceinline__ int v_rd_base(int lane) { return ((lane & 3) << 3) | (((lane >> 2) & 3) << 6) | (((lane >> 4) & 1) << 5) | (((lane >> 5) & 1) << 8); }
constexpr int v_rd_off(int d0, int ks, int half) { return d0 * 512 + ks * 4096 + half * 2048; }
template <int OFF> __device__ __forceinline__ s16x4 tr_read(int vb) {
    s16x4 r; asm volatile("ds_read_b64_tr_b16 %0, %1 offset:%2" : "=&v"(r) : "v"(vb), "i"(OFF) : "memory"); return r;
}
template <int D0> __device__ __forceinline__ void pv_one(f32x16& od, int vb, bf16x8 pa0, bf16x8 pa1, bf16x8 pa2, bf16x8 pa3) {
    const s16x4 l0 = tr_read<v_rd_off(D0, 0, 0)>(vb), h0 = tr_read<v_rd_off(D0, 0, 1)>(vb), l1 = tr_read<v_rd_off(D0, 1, 0)>(vb), h1 = tr_read<v_rd_off(D0, 1, 1)>(vb);
    const s16x4 l2 = tr_read<v_rd_off(D0, 2, 0)>(vb), h2 = tr_read<v_rd_off(D0, 2, 1)>(vb), l3 = tr_read<v_rd_off(D0, 3, 0)>(vb), h3 = tr_read<v_rd_off(D0, 3, 1)>(vb);
    asm volatile("s_waitcnt lgkmcnt(0)" ::: "memory"); SBAR();
#define PK(L, H) (bf16x8){L[0], L[1], L[2], L[3], H[0], H[1], H[2], H[3]}
    od = __builtin_amdgcn_mfma_f32_32x32x16_bf16(PK(l0, h0), pa0, od, 0, 0, 0);
    od = __builtin_amdgcn_mfma_f32_32x32x16_bf16(PK(l1, h1), pa1, od, 0, 0, 0);
    od = __builtin_amdgcn_mfma_f32_32x32x16_bf16(PK(l2, h2), pa2, od, 0, 0, 0);
    od = __builtin_amdgcn_mfma_f32_32x32x16_bf16(PK(l3, h3), pa3, od, 0, 0, 0);
#undef PK
}
__device__ __forceinline__ void pv_d0(f32x16* o, int vb, bf16x8 pa0, bf16x8 pa1, bf16x8 pa2, bf16x8 pa3) {
    pv_one<0>(o[0], vb, pa0, pa1, pa2, pa3); pv_one<1>(o[1], vb, pa0, pa1, pa2, pa3); pv_one<2>(o[2], vb, pa0, pa1, pa2, pa3); pv_one<3>(o[3], vb, pa0, pa1, pa2, pa3);
}
__device__ __forceinline__ void sb_scan(f32x16& p0, f32x16& p1, float& C, int hi) {
#pragma unroll
    for (int r = 0; r < 16; ++r) { p0[r] = __builtin_amdgcn_rcpf(1.0f + __builtin_amdgcn_exp2f(p0[r])); p1[r] = __builtin_amdgcn_rcpf(1.0f + __builtin_amdgcn_exp2f(p1[r])); }
    float gl[8], gh[8];
#pragma unroll
    for (int G = 0; G < 4; ++G) {
        const float g0 = (p0[4 * G] * p0[4 * G + 1]) * (p0[4 * G + 2] * p0[4 * G + 3]), g1 = (p1[4 * G] * p1[4 * G + 1]) * (p1[4 * G + 2] * p1[4 * G + 3]);
        auto r0 = __builtin_amdgcn_permlane32_swap(__float_as_uint(g0), __float_as_uint(g0), false, false);
        auto r1 = __builtin_amdgcn_permlane32_swap(__float_as_uint(g1), __float_as_uint(g1), false, false);
        gl[G] = __uint_as_float(r0[0]); gh[G] = __uint_as_float(r0[1]); gl[4 + G] = __uint_as_float(r1[0]); gh[4 + G] = __uint_as_float(r1[1]);
    }
    float E = C;
#pragma unroll
    for (int G = 3; G >= 0; --G) {
        float X = E * (hi ? 1.0f : gh[4 + G]);
#pragma unroll
        for (int i = 3; i >= 0; --i) { const float Pn = p1[4 * G + i] * X; p1[4 * G + i] = X - Pn; X = Pn; }
        E = E * (gl[4 + G] * gh[4 + G]);
    }
#pragma unroll
    for (int G = 3; G >= 0; --G) {
        float X = E * (hi ? 1.0f : gh[G]);
#pragma unroll
        for (int i = 3; i >= 0; --i) { const float Pn = p0[4 * G + i] * X; p0[4 * G + i] = X - Pn; X = Pn; }
        E = E * (gl[G] * gh[G]);
    }
    C = E;
}
__device__ __forceinline__ void attn_unit(int b, int h, int qb, const bf16_t* Q, const bf16_t* __restrict__ K, const bf16_t* __restrict__ V, bf16_t* O, char* shm) {
    int tid_ = threadIdx.x; asm volatile("" : "+v"(tid_));
    const int tid = tid_, lane = tid & 63, r32 = lane & 31, hi = lane >> 5; const int wid = __builtin_amdgcn_readfirstlane(tid >> 6);
    const long rowbase = (long)b * SEQ; const int q0w = qb * 256 + wid * 32;
    const bf16_t* Qw = Q + (rowbase + q0w + r32) * LD + h * HD + hi * 8;
    const bf16_t* Kh = K + rowbase * LD + h * HD; const bf16_t* Vh = V + rowbase * LD + h * HD;
    char* V_lds = shm; char* K_lds = shm + 2 * SHM_KV;
    bf16x8 qr[8];
#pragma unroll
    for (int d0 = 0; d0 < 8; ++d0) qr[d0] = *reinterpret_cast<const bf16x8*>(Qw + d0 * 16);
    f32x16 o[4]; o[0] = f32x16{}; o[1] = f32x16{}; o[2] = f32x16{}; o[3] = f32x16{};
    float C = 1.0f;
    const int sr = tid >> 4, sc = (tid & 15) * 8;
    const int vst0 = v_st(sr, sc), vst1 = v_st(32 + sr, sc), kst0 = KSWZ(sr, sc * 2), kst1 = KSWZ(32 + sr, sc * 2);
    const int vb0 = (int)(unsigned)(uintptr_t)V_lds + v_rd_base(lane);
    bf16x8 vs0, vs1, ks0, ks1;
#define SLOAD(k0) do { vs0 = *reinterpret_cast<const bf16x8*>(Vh + (long)((k0) + sr) * LD + sc); vs1 = *reinterpret_cast<const bf16x8*>(Vh + (long)((k0) + 32 + sr) * LD + sc); \
        ks0 = *reinterpret_cast<const bf16x8*>(Kh + (long)((k0) + sr) * LD + sc); ks1 = *reinterpret_cast<const bf16x8*>(Kh + (long)((k0) + 32 + sr) * LD + sc); } while (0)
#define SWRITE(bs) do { *reinterpret_cast<bf16x8*>(V_lds + (bs) * SHM_KV + vst0) = vs0; *reinterpret_cast<bf16x8*>(V_lds + (bs) * SHM_KV + vst1) = vs1; \
        *reinterpret_cast<bf16x8*>(K_lds + (bs) * SHM_KV + kst0) = ks0; *reinterpret_cast<bf16x8*>(K_lds + (bs) * SHM_KV + kst1) = ks1; } while (0)
    const int NT = 4 * qb + 4;
    unsigned* flags = reinterpret_cast<unsigned*>(shm + 4 * SHM_KV);
    bool wdone = false;
    SLOAD((NT - 1) * 64); SWRITE(0); __syncthreads();
    int cur = 0;
    for (int jt = NT - 1; jt >= 0; --jt) {
        if (jt > 0) SLOAD((jt - 1) * 64);
        const int k0 = jt * 64;
        if (k0 < q0w + 32 && !wdone) {
            f32x16 p0, p1;
            qkt(p0, p1, K_lds + cur * SHM_KV, qr, r32, hi);
            if (k0 + 64 > q0w) {
                const int trel = q0w + r32 - k0;
#pragma unroll
                for (int r = 0; r < 16; ++r) { const int kv = (r & 3) + 8 * (r >> 2) + 4 * hi; if (kv >= trel) p0[r] = -1e30f; if (kv + 32 >= trel) p1[r] = -1e30f; }
            }
            sb_scan(p0, p1, C, hi);
            bf16x8 pa0, pa1, pa2, pa3;
#define PK4(P, BASE, OUT) do { unsigned a0 = cvt_pk_bf16(P[BASE + 0], P[BASE + 1]), a1 = cvt_pk_bf16(P[BASE + 2], P[BASE + 3]);   \
    unsigned b0 = cvt_pk_bf16(P[BASE + 4], P[BASE + 5]), b1 = cvt_pk_bf16(P[BASE + 6], P[BASE + 7]);                              \
    auto r0 = __builtin_amdgcn_permlane32_swap(a0, b0, false, false); auto r1 = __builtin_amdgcn_permlane32_swap(a1, b1, false, false); \
    u32x4 w = {r0[0], r1[0], r0[1], r1[1]}; OUT = *reinterpret_cast<bf16x8*>(&w); } while (0)
            PK4(p0, 0, pa0); PK4(p0, 8, pa1); PK4(p1, 0, pa2); PK4(p1, 8, pa3);
#undef PK4
            pv_d0(o, vb0 + cur * SHM_KV, pa0, pa1, pa2, pa3);
            wdone = __all(C == 0.0f) != 0;
        }
        if (lane == 0) flags[(jt & 1) * 8 + wid] = wdone ? 1u : 0u;
        if (jt > 0) SWRITE(cur ^ 1);
        __syncthreads();
        cur ^= 1;
        const u32x4 f0 = *reinterpret_cast<const u32x4*>(flags + (jt & 1) * 8), f1 = *reinterpret_cast<const u32x4*>(flags + (jt & 1) * 8 + 4);
        if (__builtin_amdgcn_readfirstlane((int)(f0.x & f0.y & f0.z & f0.w & f1.x & f1.y & f1.z & f1.w)) != 0) break;
    }
    bf16_t* Ow = O + (rowbase + q0w + r32) * LD + h * HD + 4 * hi;
#pragma unroll
    for (int d0 = 0; d0 < 4; ++d0)
#pragma unroll
        for (int g = 0; g < 4; ++g) { u32x2 w; w.x = cvt_pk_bf16(o[d0][4 * g], o[d0][4 * g + 1]); w.y = cvt_pk_bf16(o[d0][4 * g + 2], o[d0][4 * g + 3]); *reinterpret_cast<u32x2*>(Ow + 32 * d0 + 8 * g) = w; }
#undef SLOAD
#undef SWRITE
}
}


__device__ __forceinline__ void p0_transpose_item(const float* __restrict__ W, int K, int N, bf16_t* __restrict__ WT, int row_off, const float* __restrict__ gain, LAS float* scr, int item, int lane) {
    const int nblk = N / 64, kb = item / nblk, nb = item % nblk, k0 = 64 * kb, n0 = 64 * nb;
    const int q = lane >> 4, m4 = (lane & 15) * 4;
    const float* src = W + (size_t)(k0 + q) * N + n0 + m4;
    f32x4 v[16];
#pragma unroll
    for (int i = 0; i < 16; ++i) v[i] = *(const f32x4*)(src + (size_t)(4 * i) * N);
    if (gain) {
#pragma unroll
        for (int i = 0; i < 16; ++i) v[i] = v[i] * gain[k0 + 4 * i + q];
    }
#pragma unroll
    for (int i = 0; i < 16; ++i)
#pragma unroll
        for (int j = 0; j < 4; ++j) scr[(m4 + j) * 65 + 4 * i + q] = v[i][j];
    LDS_WAIT(); asm volatile("" ::: "memory");
    const int c = lane & 7, nr = lane >> 3;
#pragma unroll
    for (int j = 0; j < 8; ++j) { const int n = nr + 8 * j; const LAS float* s = scr + n * 65 + 8 * c;
        u32x4 o; o.x = cvt_pk_bf16(s[0], s[1]); o.y = cvt_pk_bf16(s[2], s[3]); o.z = cvt_pk_bf16(s[4], s[5]); o.w = cvt_pk_bf16(s[6], s[7]);
        *(u32x4*)(WT + (size_t)(row_off + n0 + n) * K + k0 + 8 * c) = o; }
    LDS_WAIT(); asm volatile("" ::: "memory");
}
__device__ __forceinline__ void p0_diff_item(const float* __restrict__ x, bf16_t* __restrict__ diff, LAS float* rs, int T, int tid, int lane, int wave) {
    const int b = T >> 6, t0 = (T & 63) << 6; const long rb = (long)b * SEQ;
    for (int jj = 0; jj < 10; jj += 2) {
        const int i0 = wave + 8 * jj, i1 = i0 + 8, ta = t0 - 16 + i0, tb = t0 - 16 + i1;
        const f32x4* xa = (const f32x4*)(x + (rb + (ta > 0 ? ta : 0)) * DM) + lane; const f32x4* xb = (const f32x4*)(x + (rb + (tb > 0 ? tb : 0)) * DM) + lane;
        f32x4 va[8], vb[8];
#pragma unroll
        for (int j = 0; j < 8; ++j) { va[j] = xa[64 * j]; vb[j] = xb[64 * j]; }
        float sa = 0.f, sb = 0.f;
#pragma unroll
        for (int j = 0; j < 8; ++j) { sa += (va[j][0] * va[j][0] + va[j][1] * va[j][1]) + (va[j][2] * va[j][2] + va[j][3] * va[j][3]); sb += (vb[j][0] * vb[j][0] + vb[j][1] * vb[j][1]) + (vb[j][2] * vb[j][2] + vb[j][3] * vb[j][3]); }
        sa = wave_sum(sa); sb = wave_sum(sb);
        const float ra = ta >= 0 ? __builtin_amdgcn_rsqf(sa * (1.0f / DM) + EPS) : 0.f, rbv = tb >= 0 ? __builtin_amdgcn_rsqf(sb * (1.0f / DM) + EPS) : 0.f;
        if (lane == 0) { rs[i0] = ra; rs[i1] = rbv; }
    }
    __syncthreads();
    const int w = 2 << (wave >> 1);
    f32x4 h[16];
#pragma unroll
    for (int k = 0; k < 16; ++k) h[k] = (f32x4){0.f, 0.f, 0.f, 0.f};
    const float* xc = x + rb * DM + 4 * tid;
    for (int i8 = 0; i8 < 80; i8 += 8) {
        f32x4 v[8];
#pragma unroll
        for (int u = 0; u < 8; ++u) { const int t = t0 - 16 + i8 + u; v[u] = *(const f32x4*)(xc + (long)(t > 0 ? t : 0) * DM); }
#pragma unroll
        for (int u = 0; u < 8; ++u) {
            const int i = i8 + u, t = t0 - 16 + i;
#pragma unroll
            for (int k = 15; k >= 1; --k) h[k] = h[k - 1];
            h[0] = v[u] * rs[i];
            if (i8 >= 16) {
                f32x4 S = h[0] + h[1];
                if (w >= 4) S += h[2] + h[3];
                if (w >= 8) S += (h[4] + h[5]) + (h[6] + h[7]);
                if (w >= 16) S += ((h[8] + h[9]) + (h[10] + h[11])) + ((h[12] + h[13]) + (h[14] + h[15]));
                const int cnt = (t + 1 < w) ? (t + 1) : w; const float inv = 1.0f / (float)cnt;
                const f32x4 d = S * inv - h[0];
                u32x2 o; o.x = cvt_pk_bf16(d[0], d[1]); o.y = cvt_pk_bf16(d[2], d[3]);
                *(u32x2*)(diff + (rb + t) * DM + 4 * tid) = o;
            }
        }
    }
    __syncthreads();
}


#define XB_TMO      128
#define XB_XCNT(j)  (256  + 64 * (j))
#define XB_XSUB(j)  (1280 + 64 * (j))
#define XB_XGEN(j)  (2304 + 64 * (j))
#define XB_TOP      3328
#define XB_TOPGEN   3392
#define XCD_BAR_WORDS 3456
#define XB_SPIN_CAP (1u << 18)
__device__ __forceinline__ unsigned xb_ld(unsigned* p)              { return __hip_atomic_load(p, __ATOMIC_RELAXED, __HIP_MEMORY_SCOPE_AGENT); }
__device__ __forceinline__ unsigned xb_add(unsigned* p, unsigned v) { return __hip_atomic_fetch_add(p, v, __ATOMIC_RELAXED, __HIP_MEMORY_SCOPE_AGENT); }
__device__ __forceinline__ unsigned xb_xcc_id() { return (unsigned)__builtin_amdgcn_s_getreg((3 << 11) | 20) & 0xFu; }
#define XB_SPIN(cond, bar) do { unsigned _sp = 0; while (cond) { __builtin_amdgcn_s_sleep(1); \
    if ((++_sp & 255u) == 0u) { if (xb_ld(&(bar)[XB_TMO])) break; if (_sp > XB_SPIN_CAP) { atomicAdd(&(bar)[XB_TMO], 1u); break; } } } } while (0)
struct XcdBarrier { unsigned* bar; unsigned x; volatile LAS unsigned* st; };
__device__ __forceinline__ XcdBarrier xcd_barrier_post(unsigned* bar, volatile LAS unsigned* st) {
    XcdBarrier b; b.bar = bar; b.x = xb_xcc_id(); b.st = st;
    if (threadIdx.x == 0) (void)xb_add(&bar[XB_XCNT(b.x)], 1u);
    return b;
}
__device__ __forceinline__ void xcd_barrier_complete(unsigned* bar, unsigned x, unsigned& nloc, unsigned& nx) {
    const unsigned G = gridDim.x * gridDim.y * gridDim.z;
    unsigned sum, cnt, mine, sp = 0u;
    for (;;) {
        sum = 0u; cnt = 0u; mine = 0u;
#pragma unroll
        for (unsigned j = 0; j < 16; ++j) { const unsigned c = xb_ld(&bar[XB_XCNT(j)]); sum += c; cnt += (c > 0u) ? 1u : 0u; mine = (j == x) ? c : mine; }
        if (sum == G) break;
        __builtin_amdgcn_s_sleep(1);
        if ((++sp & 255u) == 0u) { if (xb_ld(&bar[XB_TMO])) break; if (sp > XB_SPIN_CAP) { atomicAdd(&bar[XB_TMO], 1u); break; } }
    }
    nloc = mine > 0u ? mine : 1u; nx = cnt > 0u ? cnt : 1u;
}
__device__ __forceinline__ void xcd_barrier(const XcdBarrier& b) {
    asm volatile("s_waitcnt vmcnt(0)" ::: "memory");
    __syncthreads();
    if (threadIdx.x == 0) {
        unsigned* bar = b.bar;
        __builtin_amdgcn_s_waitcnt(0);
        unsigned nloc = b.st[0], nx = b.st[1];
        if (nloc == 0u) { xcd_barrier_complete(bar, b.x, nloc, nx); b.st[0] = nloc; b.st[1] = nx; }
        const unsigned old = xb_add(&bar[XB_XSUB(b.x)], 1u);
        const unsigned gen = old / nloc;
        if (old + 1u == (gen + 1u) * nloc) {
            __builtin_amdgcn_fence(__ATOMIC_RELEASE, "agent");
            asm volatile("s_waitcnt vmcnt(0)" ::: "memory");
            const unsigned og = xb_add(&bar[XB_TOP], 1u);
            const unsigned tg = og / nx;
            if (og + 1u == (tg + 1u) * nx) xb_add(&bar[XB_TOPGEN], 1u);
            else XB_SPIN(xb_ld(&bar[XB_TOPGEN]) == tg, bar);
            __builtin_amdgcn_fence(__ATOMIC_ACQUIRE, "agent");
            xb_add(&bar[XB_XGEN(b.x)], 1u);
            asm volatile("s_waitcnt vmcnt(0)" ::: "memory");
        } else {
            XB_SPIN(xb_ld(&bar[XB_XGEN(b.x)]) == gen, bar);
            __builtin_amdgcn_fence(__ATOMIC_ACQUIRE, "agent");
            asm volatile("s_waitcnt vmcnt(0)" ::: "memory");
        }
    }
    __syncthreads();
}

struct Args { const float* in[13]; float* out; unsigned char* ws; };
__global__ void __launch_bounds__(512, 2) fwd_megakernel(Args args) {
    extern __shared__ __attribute__((aligned(16))) unsigned char lds_raw[];
    cg::grid_group grid = cg::this_grid();
    LAS unsigned char* lds = (LAS unsigned char*)lds_raw;
    const int tid = threadIdx.x, lane = tid & 63, wave = __builtin_amdgcn_readfirstlane(tid >> 6), G = gridDim.x, bid = blockIdx.x;
    const float* x = args.in[0]; const float* pool_norm = args.in[1]; const float* pool_w = args.in[2]; const float* pool_scale = args.in[3];
    const float* kv_norm = args.in[4]; const float* w_kv = args.in[5]; const float* attn_norm = args.in[6]; const float* w_q = args.in[7]; const float* w_o = args.in[8];
    const float* mlp_norm = args.in[9]; const float* w_up = args.in[10]; const float* w_down = args.in[11]; const float* final_norm = args.in[12];
    float* out = args.out; unsigned char* ws = args.ws;
    bf16_t* PWT = (bf16_t*)(ws + WS_PWT); bf16_t* WUPT = (bf16_t*)(ws + WS_WUPT); bf16_t* WDT = (bf16_t*)(ws + WS_WDT); bf16_t* WKVQT = (bf16_t*)(ws + WS_WKVQT); bf16_t* WOT = (bf16_t*)(ws + WS_WOT);
    float* SSQ = (float*)(ws + WS_SSQ); bf16_t* XB = (bf16_t*)(ws + WS_XB); bf16_t* HB = (bf16_t*)(ws + WS_H); bf16_t* DIFF = (bf16_t*)(ws + WS_DIFF);
    bf16_t* KB = (bf16_t*)(ws + WS_K); bf16_t* VB = (bf16_t*)(ws + WS_V); bf16_t* QB = (bf16_t*)(ws + WS_Q); bf16_t* OB = (bf16_t*)(ws + WS_O);

    unsigned* barw = (unsigned*)(ws + WS_BAR);
    volatile LAS unsigned* bst = (volatile LAS unsigned*)(lds + LDS_BYTES - 64);
    if (tid < 2) bst[tid] = 0u;
    __syncthreads();
    if (args.ws == nullptr) grid.sync();
    const XcdBarrier xbar = xcd_barrier_post(barw, bst);
#ifndef PROBE
#define PROBE 0
#endif
    for (int rep = 0; rep < (PROBE == 1 ? 2 : 1); ++rep) {
    for (int i = bid * 512 + tid; i < 4 * M; i += G * 512) SSQ[i] = 0.f;
    {
        LAS float* scr = (LAS float*)(lds + wave * 16896);
        const int gw = bid * 8 + wave, NGW = G * 8;
        constexpr int I_P = (512 / 64) * (512 / 64), I_UP = (DM / 64) * (FF / 64), I_DN = (FF / 64) * (DM / 64), I_KV = (DM / 64) * (2 * DM / 64), I_Q = (DM / 64) * (DM / 64);
        constexpr int NITEMS = 4 * I_P + 2 * I_UP + 2 * I_DN + I_KV + 2 * I_Q;
        for (int rep3 = 0; rep3 < (PROBE == 5 ? 2 : 1); ++rep3)
        for (int it = gw; it < NITEMS; it += NGW) {
            int r = it;
            if (r < 2 * I_UP) { const int l = r / I_UP; p0_transpose_item(w_up + (size_t)l * DM * FF, DM, FF, WUPT + (size_t)l * DM * FF, 0, mlp_norm + l * DM, scr, r % I_UP, lane); continue; } r -= 2 * I_UP;
            if (r < 2 * I_DN) { const int l = r / I_DN; p0_transpose_item(w_down + (size_t)l * DM * FF, FF, DM, WDT + (size_t)l * DM * FF, 0, nullptr, scr, r % I_DN, lane); continue; } r -= 2 * I_DN;
            if (r < I_KV) { p0_transpose_item(w_kv, DM, 2 * DM, WKVQT, 0, kv_norm, scr, r, lane); continue; } r -= I_KV;
            if (r < I_Q) { p0_transpose_item(w_q, DM, DM, WKVQT, 2 * DM, attn_norm, scr, r, lane); continue; } r -= I_Q;
            if (r < I_Q) { p0_transpose_item(w_o, DM, DM, WOT, 0, nullptr, scr, r, lane); continue; } r -= I_Q;
            { const int g = r / I_P; p0_transpose_item(pool_w + (size_t)g * 512 * 512, 512, 512, PWT, g * 512, pool_norm + g * 512, scr, r % I_P, lane); }
        }
    }
    __syncthreads();
    for (int rep2 = 0; rep2 < (PROBE == 4 ? 2 : 1); ++rep2)
    for (int T = bid; T < M / 64; T += G) p0_diff_item(x, DIFF, (LAS float*)(lds + 140000), T, tid, lane, wave);
    }
    xcd_barrier(xbar);

    {
        pg8::Gemm g{DIFF, PWT, M, DM, 512, DM, 1, 512}; pg8::StaticOrder S; S.init(M, DM, G, bid, 4);
        pg8::EpiRes<true> E{x, XB, pool_scale, SSQ, nullptr};
        pg8::gemm_phase<pg8::EpiRes<true>, pg8::StaticOrder, true, true>(lds, g, S, E);
    }
    xcd_barrier(xbar);
    for (int rep = 0; rep < (PROBE == 2 ? 2 : 1); ++rep) {
        pg8::Gemm g{XB, WUPT, M, FF, DM, DM, 0, 0}; pg8::StaticOrder S; S.init(M, FF, G, bid, 2);
        pg8::EpiUp E{HB};
        pg8::gemm_phase<pg8::EpiUp, pg8::StaticOrder, true, true>(lds, g, S, E);
    }
    xcd_barrier(xbar);
    {
        pg8::Gemm g{HB, WDT, M, DM, FF, FF, 0, 0}; pg8::StaticOrder S; S.init(M, DM, G, bid, 4);
        pg8::EpiRes<false> E{nullptr, XB, nullptr, SSQ + M, SSQ};
        pg8::gemm_phase<pg8::EpiRes<false>, pg8::StaticOrder, true, true>(lds, g, S, E);
    }
    xcd_barrier(xbar);
    {
        pg8::Gemm g{XB, WKVQT, M, 3 * DM, DM, DM, 0, 0}; pg8::StaticOrder S; S.init(M, 3 * DM, G, bid, 2);
        pg8::EpiKVQ E{SSQ + M, KB};
        pg8::gemm_phase<pg8::EpiKVQ, pg8::StaticOrder, true, true>(lds, g, S, E);
    }
    xcd_barrier(xbar);
    {
        for (int rep = 0; rep < (PROBE == 3 ? 2 : 1); ++rep)
        for (int L = bid; L < NBATCH * NH * 16; L += G) {
            const int c = L & 255, i = L >> 8, bh = c >> 2, j = c & 3;
            const int qb = (i == 0) ? 15 - j : (i == 1) ? 8 + j : (i == 2) ? 7 - j : j;
            att::attn_unit(bh >> 4, bh & 15, qb, QB, KB, VB, OB, (char*)lds_raw);
        }
    }
    xcd_barrier(xbar);
    {
        pg8::Gemm g{OB, WOT, M, DM, DM, DM, 0, 0}; pg8::StaticOrder S; S.init(M, DM, G, bid, 4);
        pg8::EpiRes<false> E{nullptr, XB, nullptr, SSQ + 2 * M, nullptr};
        pg8::gemm_phase<pg8::EpiRes<false>, pg8::StaticOrder, true, true>(lds, g, S, E);
    }
    xcd_barrier(xbar);
    {
        pg8::Gemm g{XB, WUPT + (size_t)DM * FF, M, FF, DM, DM, 0, 0}; pg8::StaticOrder S; S.init(M, FF, G, bid, 2);
        pg8::EpiUp E{HB};
        pg8::gemm_phase<pg8::EpiUp, pg8::StaticOrder, true, true>(lds, g, S, E);
    }
    xcd_barrier(xbar);
    if (G == 256) {
        pg8::Gemm g{HB, WDT + (size_t)DM * FF, M, DM, FF, FF, 0, 0}; pg8::StaticOrder S; S.init(M, DM, G, bid, 4);
        pg8::EpiFinal E{XB, SSQ + 2 * M, SSQ + 3 * M, barw + XCD_BAR_WORDS, final_norm, out};
        pg8::gemm_phase<pg8::EpiFinal, pg8::StaticOrder, true, true>(lds, g, S, E);
    } else {
        {
            pg8::Gemm g{HB, WDT + (size_t)DM * FF, M, DM, FF, FF, 0, 0}; pg8::StaticOrder S; S.init(M, DM, G, bid, 4);
            pg8::EpiRes<false> E{nullptr, XB, nullptr, SSQ + 3 * M, SSQ + 2 * M};
            pg8::gemm_phase<pg8::EpiRes<false>, pg8::StaticOrder, true, true>(lds, g, S, E);
        }
        xcd_barrier(xbar);
        const float* ssq = SSQ + 3 * M;
        for (int m = bid * 8 + wave; m < M; m += G * 8) {
            const float rstd = __builtin_amdgcn_rsqf(ssq[m] * (1.0f / DM) + EPS);
            const u32x4* xr = (const u32x4*)(XB + (size_t)m * DM) + lane; f32x4* orow = (f32x4*)(out + (size_t)m * DM) + 2 * lane; const f32x4* gr = (const f32x4*)final_norm + 2 * lane;
#pragma unroll
            for (int j = 0; j < 4; ++j) {
                const u32x4 q = xr[64 * j];
                const f32x4 a = (f32x4){__uint_as_float(q.x << 16), __uint_as_float(q.x & 0xffff0000u), __uint_as_float(q.y << 16), __uint_as_float(q.y & 0xffff0000u)};
                const f32x4 b = (f32x4){__uint_as_float(q.z << 16), __uint_as_float(q.z & 0xffff0000u), __uint_as_float(q.w << 16), __uint_as_float(q.w & 0xffff0000u)};
                orow[128 * j] = a * rstd * gr[128 * j]; orow[128 * j + 1] = b * rstd * gr[128 * j + 1];
            }
        }
    }
}

extern "C" void kernel_launch(void* const* d_in, const int* in_sizes, int n_in, void* d_out, int out_size, void* d_ws, size_t ws_size, hipStream_t stream) {
    static int grid = 0;
    if (grid == 0) {
        if (n_in != 13 || in_sizes[0] != M * DM || out_size != M * DM || ws_size < WS_END) { fprintf(stderr, "kernel_launch: unexpected shapes: n_in %d in0 %d out %d ws %zu (need %zu)\n", n_in, n_in > 0 ? in_sizes[0] : -1, out_size, ws_size, (size_t)WS_END); grid = -1; return; }
        int dev = 0, cus = 0, per_cu = 0;
        if (hipGetDevice(&dev) != hipSuccess || hipDeviceGetAttribute(&cus, hipDeviceAttributeMultiprocessorCount, dev) != hipSuccess) { fprintf(stderr, "kernel_launch: device query failed\n"); grid = -1; return; }
        if (hipFuncSetAttribute((const void*)fwd_megakernel, hipFuncAttributeMaxDynamicSharedMemorySize, LDS_BYTES) != hipSuccess) { fprintf(stderr, "kernel_launch: hipFuncSetAttribute failed\n"); grid = -1; return; }
        if (hipOccupancyMaxActiveBlocksPerMultiprocessor(&per_cu, (const void*)fwd_megakernel, 512, LDS_BYTES) != hipSuccess || per_cu < 1) { fprintf(stderr, "kernel_launch: occupancy query gave %d\n", per_cu); per_cu = 1; }
        (void)hipGetLastError();
        grid = cus * per_cu;
    }
    if (grid < 0) return;
    if (hipMemsetAsync((char*)d_ws + WS_BAR, 0, (XCD_BAR_WORDS + 64 * 64) * sizeof(unsigned), stream) != hipSuccess) { fprintf(stderr, "kernel_launch: hipMemsetAsync of the barrier words failed; nothing launched\n"); return; }
    Args a{};
    for (int i = 0; i < 13; ++i) a.in[i] = (const float*)d_in[i];
    a.out = (float*)d_out; a.ws = (unsigned char*)d_ws;
    void* kargs[] = {&a};
    hipError_t e = hipLaunchCooperativeKernel((const void*)fwd_megakernel, dim3(grid), dim3(512), kargs, LDS_BYTES, stream);
    if (e != hipSuccess) fprintf(stderr, "kernel_launch: cooperative launch failed: %s (grid %d)\n", hipGetErrorString(e), grid);
}
```
